# Optimizing an MI355X kernel written in HIP

```python
import jax, jax.numpy as jnp
from jax import lax
import numpy as np

D_MODEL = 1024
BATCH = 8
SEQ = 2048
DEPTH = 2
DEC_BATCH = 128
DEC_SEQ = 4
PAST_LEN = 16384
PAGE_SIZE = 128

CONV_HEADS = 4
CONV_WIDTH = D_MODEL // 4
CONV_K = 3
HG_DK = 128
HG_DV = 128
HG_HEADS = (D_MODEL // 2) // HG_DV
HG_KDIM = HG_HEADS * HG_DK
HG_WIDTH = HG_HEADS * HG_DV
HG_CHUNK = 64
POOL_WINDOWS = (2, 4, 8, 16)
POOL_WIDTH = D_MODEL // 4
POOL_GROUP = POOL_WIDTH // len(POOL_WINDOWS)
POOL_BUF = max(POOL_WINDOWS) - 1

D_MIX = CONV_WIDTH + HG_WIDTH + POOL_WIDTH
IN_SIZES = (CONV_WIDTH, CONV_WIDTH, CONV_WIDTH, CONV_WIDTH,
            HG_KDIM, HG_KDIM, HG_WIDTH, HG_WIDTH,
            POOL_WIDTH, POOL_WIDTH)
D_IN = sum(IN_SIZES)
SPLIT_IDX = tuple(int(s) for s in np.cumsum(IN_SIZES)[:-1])
EPS = 1e-6

kernel_name = "hymba_conv_hgrn2_pool_decode_step"


def _rmsnorm(x, g):
    xf = x.astype(jnp.float32)
    y = xf * lax.rsqrt(jnp.mean(xf * xf, axis=-1, keepdims=True) + EPS)
    return (y * g.astype(jnp.float32)).astype(x.dtype)


def _short_conv(a_h, a_b, a_c, a_g, w, buf):
    T = a_h.shape[1]
    u = a_c * a_h
    full = jnp.concatenate([buf.astype(u.dtype), u], axis=1)
    y = full[:, 0:T] * w[0]
    for j in range(1, CONV_K):
        y = y + full[:, j:j + T] * w[j]
    out = a_b * y * jax.nn.silu(a_g)
    return out.astype(a_h.dtype), full[:, T:]


def _hgrn2(q, f_logit, i_in, g, lb, norm_g, s0):
    B, T, _ = q.shape
    f32 = jnp.float32
    zf = f_logit.astype(f32)
    lbf = lb.astype(f32)
    logf = jnp.logaddexp(jnp.log(lbf), jnp.log1p(-lbf) + jax.nn.log_sigmoid(zf))
    k = (1.0 - lbf) * jax.nn.sigmoid(-zf)
    qh = q.astype(f32).reshape(B, T, HG_HEADS, HG_DK)
    kh = k.reshape(B, T, HG_HEADS, HG_DK)
    gh = logf.reshape(B, T, HG_HEADS, HG_DK)
    vh = i_in.astype(f32).reshape(B, T, HG_HEADS, HG_DV)
    L = min(HG_CHUNK, T)
    n = -(-T // L)
    pad = n * L - T

    def to_chunks(a):
        a = jnp.pad(a, ((0, 0), (0, pad), (0, 0), (0, 0)))
        return a.reshape(B, n, L, HG_HEADS, a.shape[-1]).transpose(1, 0, 3, 2, 4)

    qc, kc, gc, vc = to_chunks(qh), to_chunks(kh), to_chunks(gh), to_chunks(vh)
    mask = jnp.tril(jnp.ones((L, L), dtype=bool))[None, None, :, :, None]

    def step(S, inp):
        qb, kb, gb, vb = inp
        b = jnp.cumsum(gb, axis=2)
        o_inter = jnp.einsum('bhld,bhde->bhle', qb * jnp.exp(b), S)
        diff = b[:, :, :, None, :] - b[:, :, None, :, :]
        decay = jnp.exp(jnp.where(mask, diff, -jnp.inf))
        A = jnp.einsum('bhtd,bhsd,bhtsd->bhts', qb, kb, decay)
        o_intra = jnp.einsum('bhts,bhse->bhte', A, vb)
        bL = b[:, :, -1]
        S_new = jnp.exp(bL)[..., None] * S + jnp.einsum(
            'bhsd,bhse->bhde', kb * jnp.exp(bL[:, :, None, :] - b), vb)
        return S_new, o_inter + o_intra

    S_fin, o = lax.scan(step, s0.astype(f32), (qc, kc, gc, vc))
    o = o.transpose(1, 0, 3, 2, 4).reshape(B, n * L, HG_HEADS, HG_DV)[:, :T]
    o = o * lax.rsqrt(jnp.mean(o * o, axis=-1, keepdims=True) + EPS)
    o = o.reshape(B, T, HG_WIDTH) * norm_g.astype(f32)
    out = o * jax.nn.silu(g.astype(f32))
    return out.astype(q.dtype), S_fin.astype(s0.dtype)


def _pool_mixer(v, gate, buf, start, pool_w, pool_scale):
    B, T, C = v.shape
    f32 = jnp.float32
    full = jnp.concatenate([buf.astype(v.dtype), v], axis=1)
    fullf = full.astype(f32)
    csum = jnp.concatenate([jnp.zeros((B, 1, C), f32), jnp.cumsum(fullf, axis=1)], axis=1)
    pos = start + jnp.arange(T)
    means = []
    for gi, w in enumerate(POOL_WINDOWS):
        sl = slice(gi * POOL_GROUP, (gi + 1) * POOL_GROUP)
        hi = csum[:, POOL_BUF + 1:POOL_BUF + 1 + T, sl]
        lo = csum[:, POOL_BUF + 1 - w:POOL_BUF + 1 - w + T, sl]
        cnt = jnp.minimum(w, pos + 1).astype(f32)[None, :, None]
        means.append((hi - lo) / cnt)
    u = jnp.concatenate(means, axis=-1) - v.astype(f32)
    u = u.reshape(B, T, len(POOL_WINDOWS), POOL_GROUP)
    y = jnp.einsum('btgc,gcd->btgd', u, pool_w.astype(f32)).reshape(B, T, C)
    y = y * pool_scale.astype(f32) * jax.nn.silu(gate.astype(f32))
    return y.astype(v.dtype), full[:, T:]


def _trunk(x, start, conv_bufs, hg_states, pool_bufs, norm_g, w_in, conv_w, hgrn_lb,
           hgrn_norm_g, pool_w, pool_scale, w_out, final_norm_g):
    lb_all = jnp.cumsum(jax.nn.softmax(hgrn_lb.astype(jnp.float32), axis=0), axis=0)
    lb_all = lb_all - lb_all[0:1]
    new_conv, new_hg, new_pool = [], [], []
    for l in range(DEPTH):
        h = _rmsnorm(x, norm_g[l])
        z = jnp.einsum('btd,de->bte', h, w_in[l].astype(h.dtype))
        a_h, a_b, a_c, a_g, q, f, i_in, g_b, p_v, p_g = jnp.split(z, SPLIT_IDX, axis=-1)
        out_a, cb = _short_conv(a_h, a_b, a_c, a_g, conv_w[l].astype(z.dtype), conv_bufs[l])
        out_b, hs = _hgrn2(q, f, i_in, g_b, lb_all[l], hgrn_norm_g[l], hg_states[l])
        out_c, pb = _pool_mixer(p_v, p_g, pool_bufs[l], start, pool_w[l], pool_scale[l])
        mix = jnp.concatenate([out_a, out_b, out_c], axis=-1)
        x = x + jnp.einsum('bte,ed->btd', mix, w_out[l].astype(mix.dtype)).astype(x.dtype)
        new_conv.append(cb)
        new_hg.append(hs)
        new_pool.append(pb)
    y = _rmsnorm(x, final_norm_g)
    return y, jnp.stack(new_conv), jnp.stack(new_hg), jnp.stack(new_pool)


def setup_inputs(seed: int = 0) -> dict:
    key = jax.random.key(seed)
    ks = jax.random.split(key, 16)
    f32 = jnp.float32
    nrm = lambda k, s, sc: sc * jax.random.normal(k, s, f32)
    return {
        "x_prompt": nrm(ks[0], (BATCH, SEQ, D_MODEL), 1.0),
        "x_sample": nrm(ks[1], (DEC_BATCH, DEC_SEQ, D_MODEL), 1.0),
        "state_conv": nrm(ks[2], (DEPTH, DEC_BATCH, CONV_K - 1, CONV_WIDTH), 1.0),
        "state_hgrn": nrm(ks[3], (DEPTH, DEC_BATCH, HG_HEADS, HG_DK, HG_DV), 0.5),
        "state_pool": nrm(ks[4], (DEPTH, DEC_BATCH, POOL_BUF, POOL_WIDTH), 1.0),
        "norm_g": 1.0 + nrm(ks[5], (DEPTH, D_MODEL), 0.05),
        "w_in": nrm(ks[6], (DEPTH, D_MODEL, D_IN), D_MODEL ** -0.5),
        "conv_w": nrm(ks[7], (DEPTH, CONV_K, CONV_WIDTH), CONV_K ** -0.5),
        "hgrn_lb": nrm(ks[8], (DEPTH, HG_KDIM), 0.5),
        "hgrn_norm_g": 1.0 + nrm(ks[9], (DEPTH, HG_WIDTH), 0.05),
        "pool_w": nrm(ks[10], (DEPTH, len(POOL_WINDOWS), POOL_GROUP, POOL_GROUP), POOL_GROUP ** -0.5),
        "pool_scale": 1.0 + nrm(ks[11], (DEPTH, POOL_WIDTH), 0.1),
        "w_out": nrm(ks[12], (DEPTH, D_MIX, D_MODEL), D_MIX ** -0.5),
        "final_norm_g": 1.0 + nrm(ks[13], (D_MODEL,), 0.05),
    }


def reference(x_prompt, x_sample, state_conv, state_hgrn, state_pool, norm_g, w_in, conv_w,
              hgrn_lb, hgrn_norm_g, pool_w, pool_scale, w_out, final_norm_g):
    Bp = x_prompt.shape[0]
    dt = x_prompt.dtype
    zc = jnp.zeros((DEPTH, Bp, CONV_K - 1, CONV_WIDTH), dt)
    zh = jnp.zeros((DEPTH, Bp, HG_HEADS, HG_DK, HG_DV), state_hgrn.dtype)
    zp = jnp.zeros((DEPTH, Bp, POOL_BUF, POOL_WIDTH), dt)
    y_prompt, new_conv_p, new_hgrn_p, new_pool_p = _trunk(
        x_prompt, 0, zc, zh, zp, norm_g, w_in, conv_w, hgrn_lb, hgrn_norm_g,
        pool_w, pool_scale, w_out, final_norm_g)
    y_sample, new_conv_s, new_hgrn_s, new_pool_s = _trunk(
        x_sample, PAST_LEN, state_conv, state_hgrn, state_pool, norm_g, w_in, conv_w,
        hgrn_lb, hgrn_norm_g, pool_w, pool_scale, w_out, final_norm_g)
    return (y_prompt, y_sample, new_conv_p, new_hgrn_p, new_pool_p,
            new_conv_s, new_hgrn_s, new_pool_s)
```

```cpp
#include <hip/hip_runtime.h>
#include <hip/hip_cooperative_groups.h>
#include <cstdio>
namespace cg = cooperative_groups;
namespace pg8 {
#define PG8_LAS __attribute__((address_space(3)))
typedef unsigned short bf16_t;
typedef short bf16x8 __attribute__((ext_vector_type(8)));
typedef float f32x4 __attribute__((ext_vector_type(4)));
typedef unsigned u32x4 __attribute__((ext_vector_type(4)));
constexpr int BM = 256, BK = 64, HALF = 128, HTB = HALF * BK * 2  , STAGE_BYTES = 8 * HTB, NXCD = 8, WGM = 8;

__host__ __device__ __forceinline__ int lds_byte(int r, int c) { const int st = (r >> 4) * 2 + (c >> 5), rr = r & 15, cc = c & 31, ob = rr * 64 + cc * 2; return st * 1024 + (ob ^ (((ob >> 9) & 1) << 5)); }
__host__ __device__ __forceinline__ void stage_rc(int b, int& R, int& C) { const int st = b / 1024, sb = b % 1024, swz = sb ^ (((sb >> 9) & 1) << 5); R = (st >> 1) * 16 + swz / 64; C = (st & 1) * 32 + (swz % 64) / 2; }
__host__ __device__ __forceinline__ int perm32(int rho) { const int n = rho >> 4, i = rho & 15; return 8 * (i >> 2) + 4 * n + (i & 3); }

struct Unit { int pm, pn; };
struct Gemm { const bf16_t* A; const bf16_t* Bt; int M, N, K; };

struct StaticOrder {
    int nM, nN, nwg, G, c;
    __host__ __device__ void init(int M, int N, int G_, int c_) { nM = M / BM; nN = N / BM; nwg = nM * nN; G = G_; c = c_; }
    __host__ __device__ bool next(int i, Unit& u) const {
        const long L = (long)i * G + c; if (L >= nwg) return false;
        int wgid = (int)L; { const int q = nwg / NXCD, r = nwg % NXCD, xcd = wgid % NXCD, off = wgid / NXCD; wgid = (xcd < r ? xcd * (q + 1) : r * (q + 1) + (xcd - r) * q) + off; }
        const int nig = WGM * nN, gid = wgid / nig, fm = gid * WGM, gsz = (nM - fm) < WGM ? (nM - fm) : WGM;
        u.pm = fm + ((wgid % nig) % gsz); u.pn = (wgid % nig) / gsz; return true;
    }
    __device__ __forceinline__ void a_ready(const Unit&) const {}
    __device__ __forceinline__ void done(const Unit&) const {}
};
__device__ __forceinline__ unsigned cvt_pk_bf16(float lo, float hi) { unsigned r; asm volatile("v_cvt_pk_bf16_f32 %0, %1, %2" : "=v"(r) : "v"(lo), "v"(hi)); return r; }
template <class Epi, class Sched, bool STAMP = false>
__device__ __forceinline__ void gemm_phase(PG8_LAS unsigned char* lds, const Gemm g, const Sched& S, const Epi& E, unsigned long long* stamps) {
    const int tid = threadIdx.x, wid = __builtin_amdgcn_readfirstlane(tid >> 6), lane = tid & 63, wr = wid >> 2, wc = wid & 3, fr = lane & 15, fq = lane >> 4;
    const int K = g.K, nt = K / BK;
    int ts_lo = 0, ts_hi = 0, nts = 0; const unsigned long long rt_entry = STAMP ? (unsigned long long)wall_clock64() : 0ull;
#define PG8_STAMP() do { if (STAMP && wid == 0 && nts < 64) { const unsigned long long _c = (unsigned long long)clock64(); \
        ts_lo = (lane == nts) ? (int)(unsigned)_c : ts_lo; ts_hi = (lane == nts) ? (int)(unsigned)(_c >> 32) : ts_hi; ++nts; } } while (0)
    PG8_STAMP();
    unsigned voffA[2], voffB[2];
#pragma unroll
    for (int i = 0; i < 2; ++i) { int R, C; stage_rc(tid * 16 + i * 8192, R, C); const int Rb = Epi::PERM ? ((R & ~31) + perm32(R & 31)) : R;
        voffA[i] = (unsigned)(R * K + C) * 2u; voffB[i] = (unsigned)(Rb * K + C) * 2u; }
    const size_t kstep = (size_t)(BK * 2);
    const size_t hstep = (size_t)HALF * K * 2;
    const size_t tstep = 2 * hstep;
    const unsigned ldsw = (unsigned)wid * 1024u;
    const int aoff = lds_byte(wr * 64 + fr, fq * 8), boff = lds_byte(wc * 32 + fr, fq * 8);
#define PG8_SA(b, h) (((b) * 2 + (h)) * HTB)
#define PG8_SB(b, h) ((4 + (b) * 2 + (h)) * HTB)
#define PG8_STAGE(bufoff, gbase, voff) do { _Pragma("unroll") for (int _i = 0; _i < 2; ++_i) \
        __builtin_amdgcn_global_load_lds((const unsigned*)((const char*)(gbase) + (voff)[_i]), (PG8_LAS unsigned*)(lds + (bufoff) + ldsw + _i * 8192), 16, 0, 0); } while (0)
#define PG8_LDA(dst, b, h) do { _Pragma("unroll") for (int m = 0; m < 4; ++m) _Pragma("unroll") for (int k = 0; k < 2; ++k) dst[m][k] = *(const PG8_LAS bf16x8*)(lds + PG8_SA(b, h) + aoff + m * 2048 + k * 1024); } while (0)
#define PG8_LDB(dst, b, h) do { _Pragma("unroll") for (int n = 0; n < 2; ++n) _Pragma("unroll") for (int k = 0; k < 2; ++k) dst[n][k] = *(const PG8_LAS bf16x8*)(lds + PG8_SB(b, h) + boff + n * 2048 + k * 1024); } while (0)
#define PG8_MMA(ai, bj, At, Bt) do { __builtin_amdgcn_s_setprio(1); _Pragma("unroll") for (int m = 0; m < 4; ++m) _Pragma("unroll") for (int n = 0; n < 2; ++n) _Pragma("unroll") for (int k = 0; k < 2; ++k) \
        acc[ai][bj][m][n] = __builtin_amdgcn_mfma_f32_16x16x32_bf16(Bt[n][k], At[m][k], acc[ai][bj][m][n], 0, 0, 0); __builtin_amdgcn_s_setprio(0); } while (0)
#define PG8_WAIT_V(n) asm volatile("s_waitcnt vmcnt(" #n ")" ::: "memory")
#define PG8_WAIT_L(n) asm volatile("s_waitcnt lgkmcnt(" #n ")" ::: "memory")
#define PG8_BAR __builtin_amdgcn_s_barrier()
#define PG8_SCHED __builtin_amdgcn_sched_barrier(0)
    Unit cur, nxt; int ui = 0;
    if (!S.next(0, cur)) return;
    f32x4 acc[2][2][4][2];
#pragma unroll
    for (int a = 0; a < 2; ++a)
#pragma unroll
        for (int b = 0; b < 2; ++b)
#pragma unroll
            for (int m = 0; m < 4; ++m)
#pragma unroll
                for (int n = 0; n < 2; ++n) acc[a][b][m][n] = (f32x4){0.f, 0.f, 0.f, 0.f};
    bf16x8 At[4][2], B0[2][2], B1[2][2];
    const char* cA = (const char*)g.A + (size_t)cur.pm * tstep; const char* cB = (const char*)g.Bt + (size_t)cur.pn * tstep;
    S.a_ready(cur);
    PG8_STAGE(PG8_SB(0, 0), cB, voffB); PG8_STAGE(PG8_SA(0, 0), cA, voffA); PG8_STAGE(PG8_SB(0, 1), cB + hstep, voffB); PG8_STAGE(PG8_SA(0, 1), cA + hstep, voffA);
    if (wr == 1) PG8_BAR;
    PG8_WAIT_V(4); PG8_BAR;
    PG8_STAGE(PG8_SB(1, 0), cB + kstep, voffB); PG8_STAGE(PG8_SA(1, 0), cA + kstep, voffA); PG8_STAGE(PG8_SB(1, 1), cB + hstep + kstep, voffB);
    PG8_WAIT_V(6); PG8_BAR;
    PG8_STAMP();
    for (;;) {
        const bool has_next = S.next(ui + 1, nxt);
        const char* nA = has_next ? (const char*)g.A + (size_t)nxt.pm * tstep : cA; const char* nB = has_next ? (const char*)g.Bt + (size_t)nxt.pn * tstep : cB;
        for (int t = 0; t < nt; t += 2) {
            const bool last = (t == nt - 2);
            const char* a1 = cA + (size_t)(t + 1) * kstep;
            const char* a2 = last ? nA : cA + (size_t)(t + 2) * kstep; const char* b2 = last ? nB : cB + (size_t)(t + 2) * kstep;
            const char* a3 = a2 + kstep; const char* b3 = b2 + kstep;
            if (last && has_next) S.a_ready(nxt);
            PG8_LDB(B0, 0, 0); PG8_SCHED; PG8_LDA(At, 0, 0); PG8_STAGE(PG8_SA(1, 1), a1 + hstep, voffA);
            PG8_WAIT_L(8); PG8_BAR; PG8_WAIT_L(0); PG8_MMA(0, 0, At, B0); PG8_BAR; PG8_SCHED;
            PG8_LDB(B1, 0, 1); PG8_STAGE(PG8_SB(0, 0), b2, voffB);
            PG8_BAR; PG8_WAIT_L(0); PG8_MMA(0, 1, At, B1); PG8_BAR;
            PG8_LDA(At, 0, 1); PG8_STAGE(PG8_SA(0, 0), a2, voffA);
            PG8_BAR; PG8_WAIT_L(0); PG8_MMA(1, 0, At, B0); PG8_BAR; PG8_SCHED;
            PG8_STAGE(PG8_SB(0, 1), b2 + hstep, voffB);
            PG8_WAIT_V(6); PG8_BAR; PG8_MMA(1, 1, At, B1); PG8_BAR;
            PG8_LDB(B0, 1, 0); PG8_SCHED; PG8_LDA(At, 1, 0); PG8_STAGE(PG8_SA(0, 1), a2 + hstep, voffA);
            PG8_WAIT_L(8); PG8_BAR; PG8_WAIT_L(0); PG8_MMA(0, 0, At, B0); PG8_BAR; PG8_SCHED;
            PG8_LDB(B1, 1, 1); PG8_STAGE(PG8_SB(1, 0), b3, voffB);
            PG8_BAR; PG8_WAIT_L(0); PG8_MMA(0, 1, At, B1); PG8_BAR;
            PG8_LDA(At, 1, 1); PG8_STAGE(PG8_SA(1, 0), a3, voffA);
            PG8_BAR; PG8_WAIT_L(0); PG8_MMA(1, 0, At, B0); PG8_BAR; PG8_SCHED;
            PG8_STAGE(PG8_SB(1, 1), b3 + hstep, voffB);
            PG8_WAIT_V(6); PG8_BAR; PG8_MMA(1, 1, At, B1); PG8_BAR;
        }
        PG8_STAMP();
        if constexpr (!Epi::AFTER_DRAIN) { E(acc, cur, wr, wc, fr, fq); S.done(cur); }
        PG8_STAMP();
        if (!has_next) break;
#pragma unroll
        for (int a = 0; a < 2; ++a)
#pragma unroll
            for (int b = 0; b < 2; ++b)
#pragma unroll
                for (int m = 0; m < 4; ++m)
#pragma unroll
                    for (int n = 0; n < 2; ++n) acc[a][b][m][n] = (f32x4){0.f, 0.f, 0.f, 0.f};
        cur = nxt; cA = nA; cB = nB; ++ui;
    }
    PG8_WAIT_V(0);
    if (wr == 0) PG8_BAR;
    PG8_BAR;
    if constexpr (Epi::AFTER_DRAIN) { E.fused(acc, cur, wr, wc, fr, fq, lds, wid, lane); S.done(cur); }
    PG8_STAMP();
    if (STAMP && wid == 0) { stamps[lane] = lane < nts ? (((unsigned long long)(unsigned)ts_hi << 32) | (unsigned)ts_lo) : 0ull;
        if (lane == 62) stamps[62] = rt_entry; if (lane == 63) stamps[63] = (unsigned long long)wall_clock64(); }
#undef PG8_STAMP
#undef PG8_SA
#undef PG8_SB
#undef PG8_STAGE
#undef PG8_LDA
#undef PG8_LDB
#undef PG8_MMA
#undef PG8_WAIT_V
#undef PG8_WAIT_L
#undef PG8_BAR
#undef PG8_SCHED
}
}

#define DI __device__ __forceinline__
typedef pg8::bf16_t bf16_t;
typedef short bf16x8 __attribute__((ext_vector_type(8)));
typedef float f32x4 __attribute__((ext_vector_type(4)));
typedef unsigned u32x4 __attribute__((ext_vector_type(4)));
typedef unsigned u32x2 __attribute__((ext_vector_type(2)));

constexpr int MP = 16384, MS = 512, MT = MP + MS, DM = 1024, DIN = 3584, NT = 512;
constexpr int C_AH = 0, C_AB = 256, C_AC = 512, C_AG = 768, C_Q = 1024, C_F = 1536, C_I = 2048, C_GB = 2560, C_PV = 3072, C_PG = 3328;
constexpr float EPS = 1e-6f;
constexpr size_t O_Y = 0, O_NCP = 17301504, O_NHP = 17309696, O_NPP = 18358272, O_NCS = 18419712, O_NHS = 18550784, O_NPS = 35328000, O_END = 36311040;
constexpr size_t WS_WIN = 0, WS_WOUT = 14680064, WS_RSTD = 18874368, WS_DEC = 18941952, WS_XB = 19466240, WS_Z = 54069248, WS_U = 175179776, WS_END = 242288640;
constexpr int LDS_BYTES = 131072;
constexpr int L_QM = 0, L_KM = 17408, L_VT = 34816, L_ST = 53248, L_AM = 88064, L_TOT = 97280, L_EB = 99328, L_SSQ = 99840;

struct Params {
    const float *x_prompt, *x_sample, *state_conv, *state_hgrn, *state_pool, *norm_g, *w_in, *conv_w, *hgrn_lb, *hgrn_norm_g, *pool_w, *pool_scale, *w_out, *final_norm_g;
    float* out; unsigned char* ws;
};

DI float bf2f(bf16_t b) { return __uint_as_float(((unsigned)b) << 16); }
DI bf16_t f2bf(float f) { unsigned u = __float_as_uint(f); u += 0x7FFFu + ((u >> 16) & 1u); return (bf16_t)(u >> 16); }
DI unsigned pk2(float lo, float hi) { return (unsigned)f2bf(lo) | ((unsigned)f2bf(hi) << 16); }
DI void unpack8(u32x4 w, float (&o)[8]) {
    o[0] = __uint_as_float(w.x << 16); o[1] = __uint_as_float(w.x & 0xffff0000u); o[2] = __uint_as_float(w.y << 16); o[3] = __uint_as_float(w.y & 0xffff0000u);
    o[4] = __uint_as_float(w.z << 16); o[5] = __uint_as_float(w.z & 0xffff0000u); o[6] = __uint_as_float(w.w << 16); o[7] = __uint_as_float(w.w & 0xffff0000u);
}
DI int ltid() { int t = threadIdx.x; asm volatile("" : "+v"(t)); return t; }
DI float silu(float x) { return x / (1.0f + __expf(-x)); }
DI float wave_sum(float v) {
#pragma unroll
    for (int o = 32; o >= 1; o >>= 1) v += __shfl_xor(v, o, 64);
    return v;
}

struct EpiZ {
    static constexpr bool PERM = true, AFTER_DRAIN = false;
    bf16_t* O; const float* rstd;
    DI void operator()(const f32x4 (&acc)[2][2][4][2], const pg8::Unit& u, int wr, int wc, int fr, int fq) const {
        const int row0 = u.pm * 256 + wr * 64 + fr, col0 = u.pn * 256 + wc * 32 + 8 * fq;
#pragma unroll
        for (int ai = 0; ai < 2; ++ai)
#pragma unroll
            for (int m = 0; m < 4; ++m) {
                const int r = row0 + ai * 128 + m * 16; const float s = rstd[r]; bf16_t* rowp = O + (size_t)r * DIN + col0;
#pragma unroll
                for (int bj = 0; bj < 2; ++bj) { const f32x4 v0 = acc[ai][bj][m][0] * s, v1 = acc[ai][bj][m][1] * s;
                    u32x4 w; w.x = pg8::cvt_pk_bf16(v0[0], v0[1]); w.y = pg8::cvt_pk_bf16(v0[2], v0[3]); w.z = pg8::cvt_pk_bf16(v1[0], v1[1]); w.w = pg8::cvt_pk_bf16(v1[2], v1[3]);
                    *(u32x4*)(rowp + bj * 128) = w; } }
    }
};
struct EpiRes {
    static constexpr bool PERM = false, AFTER_DRAIN = false;
    float* X; const float* srcp; const float* srcs;
    DI void operator()(const f32x4 (&acc)[2][2][4][2], const pg8::Unit& u, int wr, int wc, int fr, int fq) const {
        const int row0 = u.pm * 256 + wr * 64 + fr, col0 = u.pn * 256 + wc * 32 + 4 * fq;
#pragma unroll
        for (int ai = 0; ai < 2; ++ai)
#pragma unroll
            for (int m = 0; m < 4; ++m) {
                const int r = row0 + ai * 128 + m * 16;
                const float* sp = (r < MP ? srcp + (size_t)r * DM : srcs + (size_t)(r - MP) * DM) + col0; float* rowp = X + (size_t)r * DM + col0;
#pragma unroll
                for (int bj = 0; bj < 2; ++bj)
#pragma unroll
                    for (int n = 0; n < 2; ++n) { const f32x4 o = *(const f32x4*)(sp + bj * 128 + n * 16); *(f32x4*)(rowp + bj * 128 + n * 16) = o + acc[ai][bj][m][n]; } }
    }
};

DI void phase_weights(const Params& p, unsigned char* lds) {
    const int tid = ltid(); float* t = (float*)lds;
    bf16_t* win = (bf16_t*)(p.ws + WS_WIN); bf16_t* wout = (bf16_t*)(p.ws + WS_WOUT);
    constexpr int T_IN = 2 * 16 * 56, T_OUT = 2 * 16 * 16;
    for (int ti = blockIdx.x; ti < T_IN + T_OUT; ti += gridDim.x) {
        const float* src; bf16_t* dst; const float* g; int N, kt, nt;
        if (ti < T_IN) { const int l = ti / (16 * 56), r = ti % (16 * 56); kt = r / 56; nt = r % 56; N = DIN; src = p.w_in + (size_t)l * DM * DIN; dst = win + (size_t)l * DIN * DM; g = p.norm_g + l * DM; }
        else { const int tt = ti - T_IN; const int l = tt / 256, r = tt % 256; kt = r / 16; nt = r % 16; N = DM; src = p.w_out + (size_t)l * DM * DM; dst = wout + (size_t)l * DM * DM; g = nullptr; }
#pragma unroll
        for (int i = 0; i < 2; ++i) { const int k = (tid >> 4) + 32 * i, n4 = (tid & 15) * 4;
            const float4 v = *(const float4*)(src + (size_t)(kt * 64 + k) * N + nt * 64 + n4); const float gg = g ? g[kt * 64 + k] : 1.0f;
            t[k * 65 + n4 + 0] = v.x * gg; t[k * 65 + n4 + 1] = v.y * gg; t[k * 65 + n4 + 2] = v.z * gg; t[k * 65 + n4 + 3] = v.w * gg; }
        __syncthreads();
        { const int n = tid >> 3, k8 = (tid & 7) * 8; u32x4 w;
          w.x = pk2(t[(k8 + 0) * 65 + n], t[(k8 + 1) * 65 + n]); w.y = pk2(t[(k8 + 2) * 65 + n], t[(k8 + 3) * 65 + n]);
          w.z = pk2(t[(k8 + 4) * 65 + n], t[(k8 + 5) * 65 + n]); w.w = pk2(t[(k8 + 6) * 65 + n], t[(k8 + 7) * 65 + n]);
          *(u32x4*)(dst + (size_t)(nt * 64 + n) * DM + kt * 64 + k8) = w; }
        __syncthreads();
    }
}

template <bool FINAL>
DI void phase_norm(const float* srcp, const float* srcs, bf16_t* xb, float* rstd, float* yout, const float* gfin) {
    const int tid_ = ltid(), wid = tid_ >> 6, lane = tid_ & 63;
    for (int row = blockIdx.x * 8 + wid; row < MT; row += gridDim.x * 8) {
        const float* s = row < MP ? srcp + (size_t)row * DM : srcs + (size_t)(row - MP) * DM;
        float4 v[4]; float ss = 0.f;
#pragma unroll
        for (int i = 0; i < 4; ++i) { v[i] = *(const float4*)(s + i * 256 + lane * 4); ss += v[i].x * v[i].x + v[i].y * v[i].y + v[i].z * v[i].z + v[i].w * v[i].w; }
        ss = wave_sum(ss);
        const float r = rsqrtf(ss * (1.0f / DM) + EPS);
        if (FINAL) {
#pragma unroll
            for (int i = 0; i < 4; ++i) { const float4 g = *(const float4*)(gfin + i * 256 + lane * 4);
                float4 o; o.x = v[i].x * r * g.x; o.y = v[i].y * r * g.y; o.z = v[i].z * r * g.z; o.w = v[i].w * r * g.w;
                *(float4*)(yout + (size_t)row * DM + i * 256 + lane * 4) = o; }
        } else {
            if (lane == 0) rstd[row] = r;
#pragma unroll
            for (int i = 0; i < 4; ++i) { u32x2 w; w.x = pk2(v[i].x, v[i].y); w.y = pk2(v[i].z, v[i].w); *(u32x2*)(xb + (size_t)row * DM + i * 256 + lane * 4) = w; }
        }
    }
}

DI void phase_conv(const Params& p, int l) {
    const bf16_t* z = (const bf16_t*)(p.ws + WS_Z); bf16_t* mix = (bf16_t*)(p.ws + WS_XB);
    const float* cw = p.conv_w + l * 3 * 256;
    for (int idx = blockIdx.x * NT + ltid(); idx < MT * 32; idx += gridDim.x * NT) {
        const int row = idx >> 5, c = (idx & 31) * 8;
        int t, T; const float* buf; float* nc;
        if (row < MP) { const int b = row >> 11; t = row & 2047; T = 2048; buf = nullptr; nc = p.out + O_NCP + (size_t)(l * 8 + b) * 512; }
        else { const int rr = row - MP; const int b = rr >> 2; t = rr & 3; T = 4; buf = p.state_conv + (size_t)(l * 128 + b) * 512; nc = p.out + O_NCS + (size_t)(l * 128 + b) * 512; }
        float u[3][8];
#pragma unroll
        for (int j = 0; j < 3; ++j) {
            const int tp = t - 2 + j;
            if (tp >= 0) { const bf16_t* zr = z + (size_t)(row - 2 + j) * DIN + c; float ah[8], ac[8]; unpack8(*(const u32x4*)(zr + C_AH), ah); unpack8(*(const u32x4*)(zr + C_AC), ac);
#pragma unroll
                for (int i = 0; i < 8; ++i) u[j][i] = ah[i] * ac[i]; }
            else if (buf) { const float4 a = *(const float4*)(buf + (tp + 2) * 256 + c), b4 = *(const float4*)(buf + (tp + 2) * 256 + c + 4);
                u[j][0] = a.x; u[j][1] = a.y; u[j][2] = a.z; u[j][3] = a.w; u[j][4] = b4.x; u[j][5] = b4.y; u[j][6] = b4.z; u[j][7] = b4.w; }
            else {
#pragma unroll
                for (int i = 0; i < 8; ++i) u[j][i] = 0.f; }
        }
        const bf16_t* zr = z + (size_t)row * DIN + c; float ab[8], ag[8]; unpack8(*(const u32x4*)(zr + C_AB), ab); unpack8(*(const u32x4*)(zr + C_AG), ag);
        float o[8];
#pragma unroll
        for (int i = 0; i < 8; ++i) { const float y = cw[c + i] * u[0][i] + cw[256 + c + i] * u[1][i] + cw[512 + c + i] * u[2][i]; o[i] = ab[i] * y * silu(ag[i]); }
        u32x4 w; w.x = pk2(o[0], o[1]); w.y = pk2(o[2], o[3]); w.z = pk2(o[4], o[5]); w.w = pk2(o[6], o[7]);
        *(u32x4*)(mix + (size_t)row * DM + c) = w;
        if (t >= T - 2) { float* d = nc + (t - (T - 2)) * 256 + c; *(float4*)d = make_float4(u[2][0], u[2][1], u[2][2], u[2][3]); *(float4*)(d + 4) = make_float4(u[2][4], u[2][5], u[2][6], u[2][7]); }
    }
}

DI void phase_pool(const Params& p, int l, unsigned char* lds) {
    const int tid = ltid();
    const bf16_t* z = (const bf16_t*)(p.ws + WS_Z); bf16_t* mix = (bf16_t*)(p.ws + WS_XB);
    float* pw = (float*)lds; float* ut = pw + 16384;
    for (int i = tid; i < 4096; i += NT) ((float4*)pw)[i] = ((const float4*)(p.pool_w + (size_t)l * 16384))[i];
    for (int tile = blockIdx.x; tile < 528; tile += gridDim.x) {
        __syncthreads();
        for (int it = tid; it < 1024; it += NT) {
            const int tl = it >> 5, c = (it & 31) * 8, gi = c >> 6, w = 2 << gi;
            int row, t; const float* buf; bool smp;
            if (tile < 512) { row = tile * 32 + tl; t = row & 2047; buf = nullptr; smp = false; }
            else { row = MP + (tile - 512) * 32 + tl; const int rr = row - MP; t = rr & 3; buf = p.state_pool + (size_t)(l * 128 + (rr >> 2)) * 15 * 256; smp = true; }
            float s[8], cur[8];
#pragma unroll
            for (int i = 0; i < 8; ++i) { s[i] = 0.f; cur[i] = 0.f; }
            for (int j = 0; j < w; ++j) {
                const int tp = t - j;
                if (tp >= 0) { float v[8]; unpack8(*(const u32x4*)(z + (size_t)(row - j) * DIN + C_PV + c), v);
#pragma unroll
                    for (int i = 0; i < 8; ++i) { s[i] += v[i]; if (j == 0) cur[i] = v[i]; } }
                else if (smp) { const float4 a = *(const float4*)(buf + (15 + tp) * 256 + c), b4 = *(const float4*)(buf + (15 + tp) * 256 + c + 4);
                    s[0] += a.x; s[1] += a.y; s[2] += a.z; s[3] += a.w; s[4] += b4.x; s[5] += b4.y; s[6] += b4.z; s[7] += b4.w; }
            }
            const float inv = 1.0f / (float)(smp ? w : min(w, t + 1));
#pragma unroll
            for (int i = 0; i < 8; ++i) ut[tl * 260 + c + i] = s[i] * inv - cur[i];
        }
        __syncthreads();
        for (int it = tid; it < 2048; it += NT) {
            const int tl = it >> 6, dq = it & 63, gi = dq >> 4, d4 = (dq & 15) * 4;
            float4 acc = make_float4(0.f, 0.f, 0.f, 0.f); const float* ur = ut + tl * 260 + gi * 64; const float* pwg = pw + gi * 4096 + d4;
#pragma unroll 8
            for (int c = 0; c < 64; ++c) { const float uu = ur[c]; const float4 w4 = *(const float4*)(pwg + c * 64); acc.x += uu * w4.x; acc.y += uu * w4.y; acc.z += uu * w4.z; acc.w += uu * w4.w; }
            const int row = tile < 512 ? tile * 32 + tl : MP + (tile - 512) * 32 + tl;
            const int ch = gi * 64 + d4;
            const u32x2 gw = *(const u32x2*)(z + (size_t)row * DIN + C_PG + ch);
            const float g0 = __uint_as_float(gw.x << 16), g1 = __uint_as_float(gw.x & 0xffff0000u), g2 = __uint_as_float(gw.y << 16), g3 = __uint_as_float(gw.y & 0xffff0000u);
            const float4 sc = *(const float4*)(p.pool_scale + l * 256 + ch);
            u32x2 o; o.x = pk2(acc.x * sc.x * silu(g0), acc.y * sc.y * silu(g1)); o.y = pk2(acc.z * sc.z * silu(g2), acc.w * sc.w * silu(g3));
            *(u32x2*)(mix + (size_t)row * DM + 768 + ch) = o;
        }
    }
    for (int idx = blockIdx.x * NT + tid; idx < 136 * 15 * 32; idx += gridDim.x * NT) {
        const int c = (idx & 31) * 8, r = idx >> 5, j = r % 15, bg = r / 15;
        float v[8]; float* dst;
        if (bg < 8) { unpack8(*(const u32x4*)(z + (size_t)(bg * 2048 + 2048 - 15 + j) * DIN + C_PV + c), v); dst = p.out + O_NPP + (size_t)((l * 8 + bg) * 15 + j) * 256 + c; }
        else { const int b = bg - 8, tp = j - 11; dst = p.out + O_NPS + (size_t)((l * 128 + b) * 15 + j) * 256 + c;
            if (tp < 0) { const float* sp = p.state_pool + (size_t)((l * 128 + b) * 15 + j + 4) * 256 + c; const float4 a = *(const float4*)sp, b4 = *(const float4*)(sp + 4);
                v[0] = a.x; v[1] = a.y; v[2] = a.z; v[3] = a.w; v[4] = b4.x; v[5] = b4.y; v[6] = b4.z; v[7] = b4.w; }
            else unpack8(*(const u32x4*)(z + (size_t)(MP + b * 4 + tp) * DIN + C_PV + c), v); }
        *(float4*)dst = make_float4(v[0], v[1], v[2], v[3]); *(float4*)(dst + 4) = make_float4(v[4], v[5], v[6], v[7]);
    }
    __syncthreads();
}

DI float lb_of(const Params& p, int l, int d) {
    if (l == 0) return 0.f;
    const float a0 = p.hgrn_lb[d], a1 = p.hgrn_lb[512 + d];
    return 1.0f / (1.0f + __expf(a0 - a1));
}
DI void gate_fk(float x, float lb, float& f, float& k) {
    x = fminf(fmaxf(x, -30.f), 30.f);
    const float e = __expf(-x), sig = 1.0f / (1.0f + e);
    f = lb + (1.0f - lb) * sig; k = (1.0f - lb) * (e * sig);
}

template <bool PASSC>
DI void hgrn_chunk(const Params& p, int l, int ch, unsigned char* lds) {
    const int tid = ltid(), d = tid & 127, seg = tid >> 7, wid = tid >> 6, lane = tid & 63, lr = lane & 15, lq = lane >> 4;
    const int b = ch >> 7, h = (ch >> 5) & 3, c = ch & 31, r0 = b * 2048 + c * 64;
    const bf16_t* z = (const bf16_t*)(p.ws + WS_Z); float* UT = (float*)(p.ws + WS_U) + (size_t)ch * 16384;
    float* tot = (float*)(lds + L_TOT); float* eb = (float*)(lds + L_EB);
    const float lb = lb_of(p, l, h * 128 + d);
    float cs[16], kk[16]; float cum = 0.f;
    { const bf16_t* zf = z + (size_t)(r0 + seg * 16) * DIN + C_F + h * 128 + d;
#pragma unroll
      for (int i = 0; i < 16; ++i) { float f, k; gate_fk(bf2f(zf[(size_t)i * DIN]), lb, f, k); cum += __logf(f); cs[i] = cum; kk[i] = k; } }
    tot[seg * 128 + d] = cum;
    __syncthreads();
    const float t0 = tot[d], t1 = tot[128 + d], t2 = tot[256 + d], t3 = tot[384 + d];
    const float off = seg == 0 ? 0.f : (seg == 1 ? t0 : (seg == 2 ? t0 + t1 : t0 + t1 + t2)), bref = t0 + t1, bL = bref + t2 + t3;
    { const bf16_t* zi = z + (size_t)(r0 + seg * 16) * DIN + C_I + h * 128 + d; unsigned w[8];
#pragma unroll
      for (int i = 0; i < 8; ++i) w[i] = (unsigned)zi[(size_t)(2 * i) * DIN] | ((unsigned)zi[(size_t)(2 * i + 1) * DIN] << 16);
      u32x4* dst = (u32x4*)(lds + L_VT + d * 144 + seg * 32); dst[0] = (u32x4){w[0], w[1], w[2], w[3]}; dst[1] = (u32x4){w[4], w[5], w[6], w[7]}; }
    if (!PASSC) {
        unsigned w[8];
#pragma unroll
        for (int i = 0; i < 8; ++i) w[i] = pk2(kk[2 * i] * __expf(bref - (off + cs[2 * i])), kk[2 * i + 1] * __expf(bref - (off + cs[2 * i + 1])));
        u32x4* dst = (u32x4*)(lds + L_ST + d * 144 + seg * 32); dst[0] = (u32x4){w[0], w[1], w[2], w[3]}; dst[1] = (u32x4){w[4], w[5], w[6], w[7]};
        if (seg == 0) { ((float*)(p.ws + WS_DEC))[(size_t)ch * 128 + d] = __expf(bL); eb[d] = __expf(bL - bref); }
        __syncthreads();
        f32x4 acc[8];
#pragma unroll
        for (int n = 0; n < 8; ++n) acc[n] = (f32x4){0.f, 0.f, 0.f, 0.f};
#pragma unroll
        for (int ks = 0; ks < 2; ++ks) {
            const bf16x8 a = *(const bf16x8*)(lds + L_VT + (wid * 16 + lr) * 144 + (ks * 32 + lq * 8) * 2);
#pragma unroll
            for (int n = 0; n < 8; ++n) { const bf16x8 bb = *(const bf16x8*)(lds + L_ST + (n * 16 + lr) * 144 + (ks * 32 + lq * 8) * 2);
                acc[n] = __builtin_amdgcn_mfma_f32_16x16x32_bf16(a, bb, acc[n], 0, 0, 0); }
        }
#pragma unroll
        for (int n = 0; n < 8; ++n) { const int dd = n * 16 + lr; const float sc = eb[dd];
#pragma unroll
            for (int j = 0; j < 4; ++j) UT[(size_t)(wid * 16 + lq * 4 + j) * 128 + dd] = acc[n][j] * sc; }
        __syncthreads();
    } else {
        { const bf16_t* zq = z + (size_t)(r0 + seg * 16) * DIN + C_Q + h * 128 + d;
#pragma unroll
          for (int i = 0; i < 16; ++i) { const float bb = off + cs[i]; const int t = seg * 16 + i;
              *(bf16_t*)(lds + L_QM + t * 272 + d * 2) = f2bf(bf2f(zq[(size_t)i * DIN]) * __expf(bb - bref));
              *(bf16_t*)(lds + L_KM + t * 272 + d * 2) = f2bf(kk[i] * __expf(bref - bb)); } }
        if (seg == 0) eb[d] = __expf(bref);
        __syncthreads();
#pragma unroll
        for (int i = 0; i < 8; ++i) { const int idx = tid + NT * i, e = idx >> 5, d4 = (idx & 31) * 4;
            const float4 s = *(const float4*)(UT + (size_t)e * 128 + d4);
            u32x2 w; w.x = pk2(s.x * eb[d4], s.y * eb[d4 + 1]); w.y = pk2(s.z * eb[d4 + 2], s.w * eb[d4 + 3]);
            *(u32x2*)(lds + L_ST + e * 272 + d4 * 2) = w; }
        const int tt = wid >> 1;
#pragma unroll
        for (int jj = 0; jj < 2; ++jj) {
            const int st = (wid & 1) * 2 + jj; f32x4 acc = (f32x4){0.f, 0.f, 0.f, 0.f};
            if (st <= tt) {
#pragma unroll
                for (int ks = 0; ks < 4; ++ks) { const bf16x8 a = *(const bf16x8*)(lds + L_QM + (tt * 16 + lr) * 272 + (ks * 32 + lq * 8) * 2);
                    const bf16x8 bb = *(const bf16x8*)(lds + L_KM + (st * 16 + lr) * 272 + (ks * 32 + lq * 8) * 2);
                    acc = __builtin_amdgcn_mfma_f32_16x16x32_bf16(a, bb, acc, 0, 0, 0); }
            }
#pragma unroll
            for (int j = 0; j < 4; ++j) { const int t = tt * 16 + lq * 4 + j, s = st * 16 + lr;
                *(bf16_t*)(lds + L_AM + t * 144 + s * 2) = f2bf(s <= t ? acc[j] : 0.f); }
        }
        __syncthreads();
        const int et0 = (wid & 1) * 4;
        f32x4 acc[4];
#pragma unroll
        for (int n = 0; n < 4; ++n) acc[n] = (f32x4){0.f, 0.f, 0.f, 0.f};
#pragma unroll
        for (int ks = 0; ks < 4; ++ks) { const bf16x8 a = *(const bf16x8*)(lds + L_QM + (tt * 16 + lr) * 272 + (ks * 32 + lq * 8) * 2);
#pragma unroll
            for (int n = 0; n < 4; ++n) { const bf16x8 bb = *(const bf16x8*)(lds + L_ST + ((et0 + n) * 16 + lr) * 272 + (ks * 32 + lq * 8) * 2);
                acc[n] = __builtin_amdgcn_mfma_f32_16x16x32_bf16(a, bb, acc[n], 0, 0, 0); } }
#pragma unroll
        for (int ks = 0; ks < 2; ++ks) { const bf16x8 a = *(const bf16x8*)(lds + L_AM + (tt * 16 + lr) * 144 + (ks * 32 + lq * 8) * 2);
#pragma unroll
            for (int n = 0; n < 4; ++n) { const bf16x8 bb = *(const bf16x8*)(lds + L_VT + ((et0 + n) * 16 + lr) * 144 + (ks * 32 + lq * 8) * 2);
                acc[n] = __builtin_amdgcn_mfma_f32_16x16x32_bf16(a, bb, acc[n], 0, 0, 0); } }
        float* ssq = (float*)(lds + L_SSQ);
#pragma unroll
        for (int j = 0; j < 4; ++j) { float ss = 0.f;
#pragma unroll
            for (int n = 0; n < 4; ++n) ss += acc[n][j] * acc[n][j];
            ss += __shfl_xor(ss, 1, 64); ss += __shfl_xor(ss, 2, 64); ss += __shfl_xor(ss, 4, 64); ss += __shfl_xor(ss, 8, 64);
            if (lr == 0) ssq[(tt * 16 + lq * 4 + j) * 2 + (wid & 1)] = ss; }
        __syncthreads();
        bf16_t* mix = (bf16_t*)(p.ws + WS_XB);
#pragma unroll
        for (int j = 0; j < 4; ++j) { const int t = tt * 16 + lq * 4 + j; const float rs = rsqrtf((ssq[t * 2] + ssq[t * 2 + 1]) * (1.0f / 128.0f) + EPS);
#pragma unroll
            for (int n = 0; n < 4; ++n) { const int e = (et0 + n) * 16 + lr;
                const float g = bf2f(z[(size_t)(r0 + t) * DIN + C_GB + h * 128 + e]);
                mix[(size_t)(r0 + t) * DM + 256 + h * 128 + e] = f2bf(acc[n][j] * rs * p.hgrn_norm_g[l * 512 + h * 128 + e] * silu(g)); } }
        __syncthreads();
    }
}

DI void phase_scan(const Params& p, int l) {
    float* UTb = (float*)(p.ws + WS_U); const float* dec = (const float*)(p.ws + WS_DEC);
    for (int idx = blockIdx.x * NT + ltid(); idx < 32 * 128 * 32; idx += gridDim.x * NT) {
        const int d4 = (idx & 31) * 4, e = (idx >> 5) & 127, bh = idx >> 12;
        float4 s = make_float4(0.f, 0.f, 0.f, 0.f);
#pragma unroll 8
        for (int c = 0; c < 32; ++c) { const int ch = bh * 32 + c; float4* pu = (float4*)(UTb + (size_t)ch * 16384 + e * 128 + d4);
            const float4 u = *pu; const float4 dc = *(const float4*)(dec + (size_t)ch * 128 + d4); *pu = s;
            s.x = dc.x * s.x + u.x; s.y = dc.y * s.y + u.y; s.z = dc.z * s.z + u.z; s.w = dc.w * s.w + u.w; }
        float* o = p.out + O_NHP + (size_t)(l * 32 + bh) * 16384 + e;
        o[(d4 + 0) * 128] = s.x; o[(d4 + 1) * 128] = s.y; o[(d4 + 2) * 128] = s.z; o[(d4 + 3) * 128] = s.w;
    }
}

DI void hgrn_sample(const Params& p, int l, int item, unsigned char* lds) {
    const int tid = ltid(), b = item >> 2, h = item & 3, wid = tid >> 6, lane = tid & 63;
    const bf16_t* z = (const bf16_t*)(p.ws + WS_Z);
    float* sf = (float*)lds; float* sk = sf + 512; float* sq = sk + 512; float* sv = sq + 512; float* sg = sv + 512; float* red = sg + 512; float* ssq = red + 8192;
    { const int t = tid >> 7, d = tid & 127; const bf16_t* zr = z + (size_t)(MP + b * 4 + t) * DIN + h * 128 + d;
      float f, k; gate_fk(bf2f(zr[C_F]), lb_of(p, l, h * 128 + d), f, k);
      sf[tid] = f; sk[tid] = k; sq[tid] = bf2f(zr[C_Q]); sv[tid] = bf2f(zr[C_I]); sg[tid] = bf2f(zr[C_GB]); }
    const int e4 = (tid & 31) * 4, dg = tid >> 5;
    const float* S0 = p.state_hgrn + (size_t)((l * 128 + b) * 4 + h) * 16384; float* S1 = p.out + O_NHS + (size_t)((l * 128 + b) * 4 + h) * 16384;
    float4 S[8];
#pragma unroll
    for (int i = 0; i < 8; ++i) S[i] = *(const float4*)(S0 + (size_t)(dg + 16 * i) * 128 + e4);
    __syncthreads();
#pragma unroll
    for (int t = 0; t < 4; ++t) {
        const float4 v = *(const float4*)(sv + t * 128 + e4); float4 a = make_float4(0.f, 0.f, 0.f, 0.f);
#pragma unroll
        for (int i = 0; i < 8; ++i) { const int d = t * 128 + dg + 16 * i; const float f = sf[d], k = sk[d], q = sq[d];
            S[i].x = f * S[i].x + k * v.x; S[i].y = f * S[i].y + k * v.y; S[i].z = f * S[i].z + k * v.z; S[i].w = f * S[i].w + k * v.w;
            a.x += q * S[i].x; a.y += q * S[i].y; a.z += q * S[i].z; a.w += q * S[i].w; }
        *(float4*)(red + (t * 16 + dg) * 128 + e4) = a;
    }
#pragma unroll
    for (int i = 0; i < 8; ++i) *(float4*)(S1 + (size_t)(dg + 16 * i) * 128 + e4) = S[i];
    __syncthreads();
    { const int t = tid >> 7, e = tid & 127; float o = 0.f;
#pragma unroll
      for (int g = 0; g < 16; ++g) o += red[(t * 16 + g) * 128 + e];
      const float ss = wave_sum(o * o);
      if (lane == 0) ssq[wid] = ss;
      __syncthreads();
      const float rs = rsqrtf((ssq[2 * t] + ssq[2 * t + 1]) * (1.0f / 128.0f) + EPS);
      ((bf16_t*)(p.ws + WS_XB))[(size_t)(MP + b * 4 + t) * DM + 256 + h * 128 + e] = f2bf(o * rs * p.hgrn_norm_g[l * 512 + h * 128 + e] * silu(sg[tid])); }
    __syncthreads();
}

DI Params load_params() {
    Params p{};
#if defined(__HIP_DEVICE_COMPILE__)
    typedef const __attribute__((address_space(4))) Params* KParams;
    KParams kp = (KParams)__builtin_amdgcn_kernarg_segment_ptr(); asm volatile("" : "+s"(kp));
    p.x_prompt = kp->x_prompt; p.x_sample = kp->x_sample; p.state_conv = kp->state_conv; p.state_hgrn = kp->state_hgrn; p.state_pool = kp->state_pool; p.norm_g = kp->norm_g; p.w_in = kp->w_in;
    p.conv_w = kp->conv_w; p.hgrn_lb = kp->hgrn_lb; p.hgrn_norm_g = kp->hgrn_norm_g; p.pool_w = kp->pool_w; p.pool_scale = kp->pool_scale; p.w_out = kp->w_out; p.final_norm_g = kp->final_norm_g;
    p.out = kp->out; p.ws = kp->ws;
#endif
    return p;
}
#define LP() load_params()
__global__ __launch_bounds__(512, 2) void hymba_fwd(Params p_unused) {
    extern __shared__ __attribute__((aligned(16))) unsigned char shm[];
    cg::grid_group grid = cg::this_grid();
#ifndef SK_W
    { const Params p = LP(); phase_weights(p, shm); }
#endif
    { const Params p = LP(); phase_norm<false>(p.x_prompt, p.x_sample, (bf16_t*)(p.ws + WS_XB), (float*)(p.ws + WS_RSTD), nullptr, nullptr); }
    grid.sync();
    for (int l = 0; l < 2; ++l) {
        { const Params p = LP(); pg8::Gemm g; g.A = (const bf16_t*)(p.ws + WS_XB); g.Bt = (const bf16_t*)(p.ws + WS_WIN) + (size_t)l * DIN * DM; g.M = MT; g.N = DIN; g.K = DM;
          pg8::StaticOrder S; S.init(MT, DIN, (int)gridDim.x, (int)blockIdx.x); EpiZ E; E.O = (bf16_t*)(p.ws + WS_Z); E.rstd = (const float*)(p.ws + WS_RSTD);
#ifndef SK_G1
          pg8::gemm_phase<EpiZ, pg8::StaticOrder, false>((PG8_LAS unsigned char*)shm, g, S, E, nullptr);
#endif
        }
        grid.sync();
#ifndef SK_A
        { const Params p = LP(); for (int ch = blockIdx.x; ch < 1024; ch += gridDim.x) hgrn_chunk<false>(p, l, ch, shm); }
#endif
#ifndef SK_S
        { const Params p = LP(); for (int it = blockIdx.x; it < 512; it += gridDim.x) hgrn_sample(p, l, it, shm); }
#endif
#ifndef SK_CV
        { const Params p = LP(); phase_conv(p, l); }
#endif
#ifndef SK_P
        { const Params p = LP(); phase_pool(p, l, shm); }
#endif
        grid.sync();
#ifndef SK_SC
        { const Params p = LP(); phase_scan(p, l); }
#endif
        grid.sync();
#ifndef SK_C
        { const Params p = LP(); for (int ch = blockIdx.x; ch < 1024; ch += gridDim.x) hgrn_chunk<true>(p, l, ch, shm); }
#endif
        grid.sync();
        { const Params p = LP(); float* xs = p.out + O_Y; pg8::Gemm g; g.A = (const bf16_t*)(p.ws + WS_XB); g.Bt = (const bf16_t*)(p.ws + WS_WOUT) + (size_t)l * DM * DM; g.M = MT; g.N = DM; g.K = DM;
          pg8::StaticOrder S; S.init(MT, DM, (int)gridDim.x, (int)blockIdx.x); EpiRes E; E.X = xs;
          E.srcp = l == 0 ? p.x_prompt : xs; E.srcs = l == 0 ? p.x_sample : xs + (size_t)MP * DM;
#ifndef SK_G2
          pg8::gemm_phase<EpiRes, pg8::StaticOrder, false>((PG8_LAS unsigned char*)shm, g, S, E, nullptr);
#endif
        }
        grid.sync();
        { const Params p = LP(); float* xs = p.out + O_Y;
          if (l == 0) phase_norm<false>(xs, xs + (size_t)MP * DM, (bf16_t*)(p.ws + WS_XB), (float*)(p.ws + WS_RSTD), nullptr, nullptr);
          else phase_norm<true>(xs, xs + (size_t)MP * DM, nullptr, nullptr, xs, p.final_norm_g); }
        if (l == 0) grid.sync();
    }
}

extern "C" void kernel_launch(void* const* d_in, const int* in_sizes, int n_in, void* d_out, int out_size, void* d_ws, size_t ws_size, hipStream_t stream) {
    static int grid = 0;
    if (grid == 0) {
        if (n_in != 14 || out_size != (int)O_END || ws_size < WS_END) { fprintf(stderr, "kernel_launch: unexpected shapes: n_in %d out %d ws %zu\n", n_in, out_size, ws_size); grid = -1; return; }
        int dev = 0, cus = 0, per_cu = 0;
        (void)hipGetDevice(&dev); (void)hipDeviceGetAttribute(&cus, hipDeviceAttributeMultiprocessorCount, dev);
        if (hipFuncSetAttribute((const void*)hymba_fwd, hipFuncAttributeMaxDynamicSharedMemorySize, LDS_BYTES) != hipSuccess) { fprintf(stderr, "kernel_launch: hipFuncSetAttribute failed\n"); grid = -1; return; }
        if (hipOccupancyMaxActiveBlocksPerMultiprocessor(&per_cu, (const void*)hymba_fwd, NT, LDS_BYTES) != hipSuccess || per_cu < 1) { fprintf(stderr, "kernel_launch: occupancy query failed (%d)\n", per_cu); (void)hipGetLastError(); per_cu = 1; }
        grid = cus * 1;
    }
    if (grid < 0) return;
    Params p{};
    p.x_prompt = (const float*)d_in[0]; p.x_sample = (const float*)d_in[1]; p.state_conv = (const float*)d_in[2]; p.state_hgrn = (const float*)d_in[3]; p.state_pool = (const float*)d_in[4];
    p.norm_g = (const float*)d_in[5]; p.w_in = (const float*)d_in[6]; p.conv_w = (const float*)d_in[7]; p.hgrn_lb = (const float*)d_in[8]; p.hgrn_norm_g = (const float*)d_in[9];
    p.pool_w = (const float*)d_in[10]; p.pool_scale = (const float*)d_in[11]; p.w_out = (const float*)d_in[12]; p.final_norm_g = (const float*)d_in[13];
    p.out = (float*)d_out; p.ws = (unsigned char*)d_ws;
    void* args[] = {&p};
    const hipError_t e = hipLaunchCooperativeKernel((const void*)hymba_fwd, dim3(grid), dim3(NT), args, LDS_BYTES, stream);
    if (e != hipSuccess) fprintf(stderr, "kernel_launch: cooperative launch failed: %s (grid %d)\n", hipGetErrorString(e), grid);
}
```

```cpp
#include <hip/hip_runtime.h>
#include <hip/hip_cooperative_groups.h>
#include <cstdio>
namespace cg = cooperative_groups;
namespace pg8 {
#define PG8_LAS __attribute__((address_space(3)))
typedef unsigned short bf16_t;
typedef short bf16x8 __attribute__((ext_vector_type(8)));
typedef float f32x4 __attribute__((ext_vector_type(4)));
typedef unsigned u32x4 __attribute__((ext_vector_type(4)));
constexpr int BM = 256, BK = 64, HALF = 128, HTB = HALF * BK * 2  , STAGE_BYTES = 8 * HTB, NXCD = 8, WGM = 8;

__host__ __device__ __forceinline__ int lds_byte(int r, int c) { const int st = (r >> 4) * 2 + (c >> 5), rr = r & 15, cc = c & 31, ob = rr * 64 + cc * 2; return st * 1024 + (ob ^ (((ob >> 9) & 1) << 5)); }
__host__ __device__ __forceinline__ void stage_rc(int b, int& R, int& C) { const int st = b / 1024, sb = b % 1024, swz = sb ^ (((sb >> 9) & 1) << 5); R = (st >> 1) * 16 + swz / 64; C = (st & 1) * 32 + (swz % 64) / 2; }
__host__ __device__ __forceinline__ int perm32(int rho) { const int n = rho >> 4, i = rho & 15; return 8 * (i >> 2) + 4 * n + (i & 3); }

struct Unit { int pm, pn; };
struct Gemm { const bf16_t* A; const bf16_t* Bt; int M, N, K; };

struct StaticOrder {
    int nM, nN, nwg, G, c;
    __host__ __device__ void init(int M, int N, int G_, int c_) { nM = M / BM; nN = N / BM; nwg = nM * nN; G = G_; c = c_; }
    __host__ __device__ bool next(int i, Unit& u) const {
        const long L = (long)i * G + c; if (L >= nwg) return false;
        int wgid = (int)L; { const int q = nwg / NXCD, r = nwg % NXCD, xcd = wgid % NXCD, off = wgid / NXCD; wgid = (xcd < r ? xcd * (q + 1) : r * (q + 1) + (xcd - r) * q) + off; }
        const int nig = WGM * nN, gid = wgid / nig, fm = gid * WGM, gsz = (nM - fm) < WGM ? (nM - fm) : WGM;
        u.pm = fm + ((wgid % nig) % gsz); u.pn = (wgid % nig) / gsz; return true;
    }
    __device__ __forceinline__ void a_ready(const Unit&) const {}
    __device__ __forceinline__ void done(const Unit&) const {}
};
__device__ __forceinline__ unsigned cvt_pk_bf16(float lo, float hi) { unsigned r; asm volatile("v_cvt_pk_bf16_f32 %0, %1, %2" : "=v"(r) : "v"(lo), "v"(hi)); return r; }
template <class Epi, class Sched, bool STAMP = false>
__device__ __forceinline__ void gemm_phase(PG8_LAS unsigned char* lds, const Gemm g, const Sched& S, const Epi& E, unsigned long long* stamps) {
    int tid_l = threadIdx.x; asm volatile("" : "+v"(tid_l));
    const int tid = tid_l, wid = __builtin_amdgcn_readfirstlane(tid >> 6), lane = tid & 63, wr = wid >> 2, wc = wid & 3, fr = lane & 15, fq = lane >> 4;
    const int K = g.K, nt = K / BK;
    int ts_lo = 0, ts_hi = 0, nts = 0; const unsigned long long rt_entry = STAMP ? (unsigned long long)wall_clock64() : 0ull;
#define PG8_STAMP() do { if (STAMP && wid == 0 && nts < 64) { const unsigned long long _c = (unsigned long long)clock64(); \
        ts_lo = (lane == nts) ? (int)(unsigned)_c : ts_lo; ts_hi = (lane == nts) ? (int)(unsigned)(_c >> 32) : ts_hi; ++nts; } } while (0)
    PG8_STAMP();
    unsigned voffA[2], voffB[2];
#pragma unroll
    for (int i = 0; i < 2; ++i) { int R, C; stage_rc(tid * 16 + i * 8192, R, C); const int Rb = Epi::PERM ? ((R & ~31) + perm32(R & 31)) : R;
        voffA[i] = (unsigned)(R * K + C) * 2u; voffB[i] = (unsigned)(Rb * K + C) * 2u; }
    const size_t kstep = (size_t)(BK * 2);
    const size_t hstep = (size_t)HALF * K * 2;
    const size_t tstep = 2 * hstep;
    const unsigned ldsw = (unsigned)wid * 1024u;
    const int aoff = lds_byte(wr * 64 + fr, fq * 8), boff = lds_byte(wc * 32 + fr, fq * 8);
#define PG8_SA(b, h) (((b) * 2 + (h)) * HTB)
#define PG8_SB(b, h) ((4 + (b) * 2 + (h)) * HTB)
#define PG8_STAGE(bufoff, gbase, voff) do { _Pragma("unroll") for (int _i = 0; _i < 2; ++_i) \
        __builtin_amdgcn_global_load_lds((const unsigned*)((const char*)(gbase) + (voff)[_i]), (PG8_LAS unsigned*)(lds + (bufoff) + ldsw + _i * 8192), 16, 0, 0); } while (0)
#define PG8_LDA(dst, b, h) do { _Pragma("unroll") for (int m = 0; m < 4; ++m) _Pragma("unroll") for (int k = 0; k < 2; ++k) dst[m][k] = *(const PG8_LAS bf16x8*)(lds + PG8_SA(b, h) + aoff + m * 2048 + k * 1024); } while (0)
#define PG8_LDB(dst, b, h) do { _Pragma("unroll") for (int n = 0; n < 2; ++n) _Pragma("unroll") for (int k = 0; k < 2; ++k) dst[n][k] = *(const PG8_LAS bf16x8*)(lds + PG8_SB(b, h) + boff + n * 2048 + k * 1024); } while (0)
#define PG8_MMA(ai, bj, At, Bt) do { __builtin_amdgcn_s_setprio(1); _Pragma("unroll") for (int m = 0; m < 4; ++m) _Pragma("unroll") for (int n = 0; n < 2; ++n) _Pragma("unroll") for (int k = 0; k < 2; ++k) \
        acc[ai][bj][m][n] = __builtin_amdgcn_mfma_f32_16x16x32_bf16(Bt[n][k], At[m][k], acc[ai][bj][m][n], 0, 0, 0); __builtin_amdgcn_s_setprio(0); } while (0)
#define PG8_WAIT_V(n) asm volatile("s_waitcnt vmcnt(" #n ")" ::: "memory")
#define PG8_WAIT_L(n) asm volatile("s_waitcnt lgkmcnt(" #n ")" ::: "memory")
#define PG8_BAR __builtin_amdgcn_s_barrier()
#define PG8_SCHED __builtin_amdgcn_sched_barrier(0)
    Unit cur, nxt; int ui = 0;
    if (!S.next(0, cur)) return;
    f32x4 acc[2][2][4][2];
#pragma unroll
    for (int a = 0; a < 2; ++a)
#pragma unroll
        for (int b = 0; b < 2; ++b)
#pragma unroll
            for (int m = 0; m < 4; ++m)
#pragma unroll
                for (int n = 0; n < 2; ++n) acc[a][b][m][n] = (f32x4){0.f, 0.f, 0.f, 0.f};
    bf16x8 At[4][2], B0[2][2], B1[2][2];
    const char* cA = (const char*)g.A + (size_t)cur.pm * tstep; const char* cB = (const char*)g.Bt + (size_t)cur.pn * tstep;
    S.a_ready(cur);
    PG8_STAGE(PG8_SB(0, 0), cB, voffB); PG8_STAGE(PG8_SA(0, 0), cA, voffA); PG8_STAGE(PG8_SB(0, 1), cB + hstep, voffB); PG8_STAGE(PG8_SA(0, 1), cA + hstep, voffA);
    if (wr == 1) PG8_BAR;
    PG8_WAIT_V(4); PG8_BAR;
    PG8_STAGE(PG8_SB(1, 0), cB + kstep, voffB); PG8_STAGE(PG8_SA(1, 0), cA + kstep, voffA); PG8_STAGE(PG8_SB(1, 1), cB + hstep + kstep, voffB);
    PG8_WAIT_V(6); PG8_BAR;
    PG8_STAMP();
    for (;;) {
        const bool has_next = S.next(ui + 1, nxt);
        const char* nA = has_next ? (const char*)g.A + (size_t)nxt.pm * tstep : cA; const char* nB = has_next ? (const char*)g.Bt + (size_t)nxt.pn * tstep : cB;
        for (int t = 0; t < nt; t += 2) {
            const bool last = (t == nt - 2);
            const char* a1 = cA + (size_t)(t + 1) * kstep;
            const char* a2 = last ? nA : cA + (size_t)(t + 2) * kstep; const char* b2 = last ? nB : cB + (size_t)(t + 2) * kstep;
            const char* a3 = a2 + kstep; const char* b3 = b2 + kstep;
            if (last && has_next) S.a_ready(nxt);
            if (last) E.prefetch(cur, wr, fr, lds, wid);
            PG8_LDB(B0, 0, 0); PG8_SCHED; PG8_LDA(At, 0, 0); PG8_STAGE(PG8_SA(1, 1), a1 + hstep, voffA);
            PG8_WAIT_L(8); PG8_BAR; PG8_WAIT_L(0); PG8_MMA(0, 0, At, B0); PG8_BAR; PG8_SCHED;
            PG8_LDB(B1, 0, 1); PG8_STAGE(PG8_SB(0, 0), b2, voffB);
            PG8_BAR; PG8_WAIT_L(0); PG8_MMA(0, 1, At, B1); PG8_BAR;
            PG8_LDA(At, 0, 1); PG8_STAGE(PG8_SA(0, 0), a2, voffA);
            PG8_BAR; PG8_WAIT_L(0); PG8_MMA(1, 0, At, B0); PG8_BAR; PG8_SCHED;
            PG8_STAGE(PG8_SB(0, 1), b2 + hstep, voffB);
            PG8_WAIT_V(6); PG8_BAR; PG8_MMA(1, 1, At, B1); PG8_BAR;
            PG8_LDB(B0, 1, 0); PG8_SCHED; PG8_LDA(At, 1, 0); PG8_STAGE(PG8_SA(0, 1), a2 + hstep, voffA);
            PG8_WAIT_L(8); PG8_BAR; PG8_WAIT_L(0); PG8_MMA(0, 0, At, B0); PG8_BAR; PG8_SCHED;
            PG8_LDB(B1, 1, 1); PG8_STAGE(PG8_SB(1, 0), b3, voffB);
            PG8_BAR; PG8_WAIT_L(0); PG8_MMA(0, 1, At, B1); PG8_BAR;
            PG8_LDA(At, 1, 1); PG8_STAGE(PG8_SA(1, 0), a3, voffA);
            PG8_BAR; PG8_WAIT_L(0); PG8_MMA(1, 0, At, B0); PG8_BAR; PG8_SCHED;
            PG8_STAGE(PG8_SB(1, 1), b3 + hstep, voffB);
            PG8_WAIT_V(6); PG8_BAR; PG8_MMA(1, 1, At, B1); PG8_BAR;
        }
        PG8_STAMP();
        if constexpr (!Epi::AFTER_DRAIN) { E(acc, cur, wr, wc, fr, fq, lds, wid, lane); S.done(cur); }
        PG8_STAMP();
        if (!has_next) break;
#pragma unroll
        for (int a = 0; a < 2; ++a)
#pragma unroll
            for (int b = 0; b < 2; ++b)
#pragma unroll
                for (int m = 0; m < 4; ++m)
#pragma unroll
                    for (int n = 0; n < 2; ++n) acc[a][b][m][n] = (f32x4){0.f, 0.f, 0.f, 0.f};
        cur = nxt; cA = nA; cB = nB; ++ui;
    }
    PG8_WAIT_V(0);
    if (wr == 0) PG8_BAR;
    PG8_BAR;
    if constexpr (Epi::AFTER_DRAIN) { E.fused(acc, cur, wr, wc, fr, fq, lds, wid, lane); S.done(cur); }
    PG8_STAMP();
    if (STAMP && wid == 0) { stamps[lane] = lane < nts ? (((unsigned long long)(unsigned)ts_hi << 32) | (unsigned)ts_lo) : 0ull;
        if (lane == 62) stamps[62] = rt_entry; if (lane == 63) stamps[63] = (unsigned long long)wall_clock64(); }
#undef PG8_STAMP
#undef PG8_SA
#undef PG8_SB
#undef PG8_STAGE
#undef PG8_LDA
#undef PG8_LDB
#undef PG8_MMA
#undef PG8_WAIT_V
#undef PG8_WAIT_L
#undef PG8_BAR
#undef PG8_SCHED
}
}
#define XB_TMO      128
#define XB_XCNT(j)  (256  + 64 * (j))
#define XB_XSUB(j)  (1280 + 64 * (j))
#define XB_XGEN(j)  (2304 + 64 * (j))
#define XB_TOP      3328
#define XB_TOPGEN   3392
#define XCD_BAR_WORDS 3456
#define XB_SPIN_CAP (1u << 18)
#define LAS __attribute__((address_space(3)))

__device__ __forceinline__ unsigned xb_ld(unsigned* p)              { return __hip_atomic_load(p, __ATOMIC_RELAXED, __HIP_MEMORY_SCOPE_AGENT); }
__device__ __forceinline__ unsigned xb_add(unsigned* p, unsigned v) { return __hip_atomic_fetch_add(p, v, __ATOMIC_RELAXED, __HIP_MEMORY_SCOPE_AGENT); }
__device__ __forceinline__ unsigned xb_xcc_id() { return (unsigned)__builtin_amdgcn_s_getreg((3 << 11) | 20) & 0xFu; }
#define XB_SPIN(cond, bar) do { unsigned _sp = 0; while (cond) { __builtin_amdgcn_s_sleep(1); \
    if ((++_sp & 255u) == 0u) { if (xb_ld(&(bar)[XB_TMO])) break; if (_sp > XB_SPIN_CAP) { atomicAdd(&(bar)[XB_TMO], 1u); break; } } } } while (0)

struct XcdBarrier {
    unsigned* bar; unsigned x;
    volatile LAS unsigned* st;
};

__device__ __forceinline__ XcdBarrier xcd_barrier_post(unsigned* bar, volatile LAS unsigned* st) {
    XcdBarrier b; b.bar = bar; b.x = xb_xcc_id(); b.st = st;
    if (threadIdx.x == 0) (void)xb_add(&bar[XB_XCNT(b.x)], 1u);
    return b;
}
__device__ __forceinline__ void xcd_barrier_complete(unsigned* bar, unsigned x, unsigned& nloc, unsigned& nx) {
    const unsigned G = gridDim.x * gridDim.y * gridDim.z;
    unsigned sum, cnt, mine, sp = 0u;
    for (;;) {
        sum = 0u; cnt = 0u; mine = 0u;
#pragma unroll
        for (unsigned j = 0; j < 16; ++j) { const unsigned c = xb_ld(&bar[XB_XCNT(j)]); sum += c; cnt += (c > 0u) ? 1u : 0u; mine = (j == x) ? c : mine; }
        if (sum == G) break;
        __builtin_amdgcn_s_sleep(1);
        if ((++sp & 255u) == 0u) { if (xb_ld(&bar[XB_TMO])) break; if (sp > XB_SPIN_CAP) { atomicAdd(&bar[XB_TMO], 1u); break; } }
    }
    nloc = mine > 0u ? mine : 1u; nx = cnt > 0u ? cnt : 1u;
}

__device__ __forceinline__ void xcd_barrier(const XcdBarrier& b) {
    asm volatile("s_waitcnt vmcnt(0)" ::: "memory");
    __syncthreads();
    if (threadIdx.x == 0) {
        unsigned* bar = b.bar;
        __builtin_amdgcn_s_waitcnt(0);
        unsigned nloc = b.st[0], nx = b.st[1];
        if (nloc == 0u) { xcd_barrier_complete(bar, b.x, nloc, nx); b.st[0] = nloc; b.st[1] = nx; }
        const unsigned old = xb_add(&bar[XB_XSUB(b.x)], 1u);
        const unsigned gen = old / nloc;
        if (old + 1u == (gen + 1u) * nloc) {
            __builtin_amdgcn_fence(__ATOMIC_RELEASE, "agent");
            asm volatile("s_waitcnt vmcnt(0)" ::: "memory");
            const unsigned og = xb_add(&bar[XB_TOP], 1u);
            const unsigned tg = og / nx;
            if (og + 1u == (tg + 1u) * nx) xb_add(&bar[XB_TOPGEN], 1u);
            else XB_SPIN(xb_ld(&bar[XB_TOPGEN]) == tg, bar);
            __builtin_amdgcn_fence(__ATOMIC_ACQUIRE, "agent");
            xb_add(&bar[XB_XGEN(b.x)], 1u);
            asm volatile("s_waitcnt vmcnt(0)" ::: "memory");
        } else {
            XB_SPIN(xb_ld(&bar[XB_XGEN(b.x)]) == gen, bar);
            __builtin_amdgcn_fence(__ATOMIC_ACQUIRE, "agent");
            asm volatile("s_waitcnt vmcnt(0)" ::: "memory");
        }
    }
    __syncthreads();
}


#define DI __device__ __forceinline__
typedef pg8::bf16_t bf16_t;
typedef short bf16x8 __attribute__((ext_vector_type(8)));
typedef float f32x4 __attribute__((ext_vector_type(4)));
typedef unsigned u32x4 __attribute__((ext_vector_type(4)));
typedef unsigned u32x2 __attribute__((ext_vector_type(2)));

constexpr int MP = 16384, MS = 512, MT = MP + MS, DM = 1024, DIN = 3584, NT = 512;
constexpr int C_AH = 0, C_AB = 256, C_AC = 512, C_AG = 768, C_Q = 1024, C_F = 1536, C_I = 2048, C_GB = 2560, C_PV = 3072, C_PG = 3328;
constexpr float EPS = 1e-6f;
constexpr size_t O_Y = 0, O_NCP = 17301504, O_NHP = 17309696, O_NPP = 18358272, O_NCS = 18419712, O_NHS = 18550784, O_NPS = 35328000, O_END = 36311040;
constexpr size_t WS_WIN = 0, WS_WOUT = 14680064, WS_RSTD = 18874368, WS_DEC = 18941952, WS_XB = 19466240, WS_Z = 54069248, WS_U = 175179776, WS_BAR = 242288640, WS_SSQ = 242288640 + 16384, WS_XSN = 242288640 + 16384 + 3 * 67584, WS_EBR = 242288640 + 16384 + 3 * 67584 + 1048576, WS_END = 242288640 + 16384 + 3 * 67584 + 1048576 + 524288;
#ifndef PASSC_PREFETCH
#define PASSC_PREFETCH 1
#endif
constexpr int GRID = 256;
constexpr int EPF_OFF = 131072 + 64;
constexpr int LDS_BYTES = 131072 + 64 + 16384;
constexpr int L_QM = 0, L_KM = 17408, L_VT = 34816, L_ST = 53248, L_AM = 88064, L_TOT = 97280, L_EB = 101376, L_SSQ = 101888;

struct Params {
    const float *x_prompt, *x_sample, *state_conv, *state_hgrn, *state_pool, *norm_g, *w_in, *conv_w, *hgrn_lb, *hgrn_norm_g, *pool_w, *pool_scale, *w_out, *final_norm_g;
    float* out; unsigned char* ws;
};

DI float bf2f(bf16_t b) { return __uint_as_float(((unsigned)b) << 16); }
typedef __bf16 hbf2 __attribute__((ext_vector_type(2)));
typedef float hf2 __attribute__((ext_vector_type(2)));
DI unsigned pk2(float lo, float hi) { const hf2 v = {lo, hi}; return __builtin_bit_cast(unsigned, __builtin_convertvector(v, hbf2)); }
DI bf16_t f2bf(float f) { return (bf16_t)(pk2(f, f) & 0xffffu); }
DI float frcp(float x) { return __builtin_amdgcn_rcpf(x); }
DI void unpack8(u32x4 w, float (&o)[8]) {
    o[0] = __uint_as_float(w.x << 16); o[1] = __uint_as_float(w.x & 0xffff0000u); o[2] = __uint_as_float(w.y << 16); o[3] = __uint_as_float(w.y & 0xffff0000u);
    o[4] = __uint_as_float(w.z << 16); o[5] = __uint_as_float(w.z & 0xffff0000u); o[6] = __uint_as_float(w.w << 16); o[7] = __uint_as_float(w.w & 0xffff0000u);
}
DI int ltid() { int t = threadIdx.x; asm volatile("" : "+v"(t)); return t; }
DI float4 ldnt4(const float* p) { const f32x4 v = __builtin_nontemporal_load((const f32x4*)p); return make_float4(v[0], v[1], v[2], v[3]); }
DI void stnt4(float* p, float4 v) { const f32x4 w = {v.x, v.y, v.z, v.w}; __builtin_nontemporal_store(w, (f32x4*)p); }
DI float silu(float x) { return x * frcp(1.0f + __expf(-x)); }
DI float wave_sum(float v) {
#pragma unroll
    for (int o = 32; o >= 1; o >>= 1) v += __shfl_xor(v, o, 64);
    return v;
}

struct EpiZ {
    static constexpr bool PERM = true, AFTER_DRAIN = false;
    bf16_t* O; const float* ssq;
    DI void prefetch(const pg8::Unit& u, int wr, int fr, PG8_LAS unsigned char* lds, int wid) const {
        if (ssq) { const float* g = ssq + u.pm * 256 + wr * 64 + fr;
#pragma unroll
            for (int i = 0; i < 8; ++i) __builtin_amdgcn_global_load_lds((const unsigned*)(g + (i >> 2) * 128 + (i & 3) * 16), (PG8_LAS unsigned*)(lds + EPF_OFF + wid * 2048 + i * 256), 4, 0, 0); }
    }
    DI void operator()(const f32x4 (&acc)[2][2][4][2], const pg8::Unit& u, int wr, int wc, int fr, int fq, PG8_LAS unsigned char* lds, int wid, int lane) const {
        const int row0 = u.pm * 256 + wr * 64 + fr, col0 = u.pn * 256 + wc * 32 + 8 * fq;
#pragma unroll
        for (int ai = 0; ai < 2; ++ai)
#pragma unroll
            for (int m = 0; m < 4; ++m) {
                const int r = row0 + ai * 128 + m * 16; const float s = ssq ? rsqrtf(*(const PG8_LAS float*)(lds + EPF_OFF + wid * 2048 + (ai * 4 + m) * 256 + lane * 4) * (1.0f / DM) + EPS) : 1.0f; bf16_t* rowp = O + (size_t)r * DIN + col0;
#pragma unroll
                for (int bj = 0; bj < 2; ++bj) { const f32x4 v0 = acc[ai][bj][m][0] * s, v1 = acc[ai][bj][m][1] * s;
                    u32x4 w; w.x = pg8::cvt_pk_bf16(v0[0], v0[1]); w.y = pg8::cvt_pk_bf16(v0[2], v0[3]); w.z = pg8::cvt_pk_bf16(v1[0], v1[1]); w.w = pg8::cvt_pk_bf16(v1[2], v1[3]);
                    *(u32x4*)(rowp + bj * 128) = w; } }
    }
};
struct EpiRes {
    static constexpr bool PERM = false, AFTER_DRAIN = true;
    float* X; const float* src; float* ssq; bf16_t* xbn;
    DI void prefetch(const pg8::Unit&, int, int, PG8_LAS unsigned char*, int) const {}
    DI void operator()(const f32x4 (&)[2][2][4][2], const pg8::Unit&, int, int, int, int, PG8_LAS unsigned char*, int, int) const {}
    DI void fused(const f32x4 (&acc)[2][2][4][2], const pg8::Unit& u, int wr, int wc, int fr, int fq, PG8_LAS unsigned char* lds, int wid, int lane) const {
        typedef PG8_LAS f32x4* LP4;
#pragma unroll
        for (int ai = 0; ai < 2; ++ai) {
#pragma unroll
            for (int m = 0; m < 4; ++m) { const int rl = wr * 64 + m * 16 + fr;
#pragma unroll
                for (int bj = 0; bj < 2; ++bj)
#pragma unroll
                    for (int n = 0; n < 2; ++n) { const int c4 = bj * 32 + wc * 8 + n * 4 + fq; *(LP4)(lds + rl * 1024 + ((c4 ^ (rl & 15)) << 4)) = acc[ai][bj][m][n]; } }
            __syncthreads();
#pragma unroll
            for (int half = 0; half < 2; ++half) {
                f32x4 sv[8];
#pragma unroll
                for (int rr = 0; rr < 8; ++rr) { const int row = wid * 16 + half * 8 + rr; const size_t go = (size_t)(u.pm * 256 + ai * 128 + row) * DM + u.pn * 256 + lane * 4; sv[rr] = __builtin_nontemporal_load((const f32x4*)(src + go)); }
                float part[8];
#pragma unroll
                for (int rr = 0; rr < 8; ++rr) { const int row = wid * 16 + half * 8 + rr; const int gr = u.pm * 256 + ai * 128 + row; const size_t go = (size_t)gr * DM + u.pn * 256 + lane * 4;
                    const f32x4 o = sv[rr] + *(LP4)(lds + row * 1024 + ((lane ^ (row & 15)) << 4));
                    *(f32x4*)(X + go) = o;
                    if (xbn) { u32x2 w; w.x = pk2(o[0], o[1]); w.y = pk2(o[2], o[3]); *(u32x2*)(xbn + go) = w; }
                    part[rr] = o[0] * o[0] + o[1] * o[1] + o[2] * o[2] + o[3] * o[3]; }
                { const bool h1 = (lane & 32) != 0, h2 = (lane & 16) != 0, h3 = (lane & 8) != 0; float q4[4], q2[2];
#pragma unroll
                  for (int i = 0; i < 4; ++i) { const float snd = h1 ? part[i] : part[i + 4], kp = h1 ? part[i + 4] : part[i]; q4[i] = kp + __shfl_xor(snd, 32, 64); }
#pragma unroll
                  for (int i = 0; i < 2; ++i) { const float snd = h2 ? q4[i] : q4[i + 2], kp = h2 ? q4[i + 2] : q4[i]; q2[i] = kp + __shfl_xor(snd, 16, 64); }
                  float q1; { const float snd = h3 ? q2[0] : q2[1], kp = h3 ? q2[1] : q2[0]; q1 = kp + __shfl_xor(snd, 8, 64); }
                  q1 += __shfl_xor(q1, 4, 64); q1 += __shfl_xor(q1, 2, 64); q1 += __shfl_xor(q1, 1, 64);
                  const int rsel = (h3 ? 1 : 0) + (h2 ? 2 : 0) + (h1 ? 4 : 0);
                  if ((lane & 7) == 0) (void)__hip_atomic_fetch_add(ssq + u.pm * 256 + ai * 128 + wid * 16 + half * 8 + rsel, q1, __ATOMIC_RELAXED, __HIP_MEMORY_SCOPE_AGENT); }
            }
            __syncthreads();
        }
    }
};

struct WTile { const float* src; bf16_t* dst; const float* g; int N, kt, nt4; };
DI WTile wtile_of(const Params& p, int ti) {
    WTile w;
    bf16_t* win = (bf16_t*)(p.ws + WS_WIN); bf16_t* wout = (bf16_t*)(p.ws + WS_WOUT);
    if (ti < 448) { const int l = ti / 224, r = ti % 224; w.kt = r / 14; w.nt4 = r % 14; w.N = DIN; w.src = p.w_in + (size_t)l * DM * DIN; w.dst = win + (size_t)l * DIN * DM; w.g = p.norm_g + l * DM; }
    else { const int tt = ti - 448; const int l = tt / 64, r = tt % 64; w.kt = r / 4; w.nt4 = r % 4; w.N = DM; w.src = p.w_out + (size_t)l * DM * DM; w.dst = wout + (size_t)l * DM * DM; w.g = nullptr; }
    return w;
}
DI void wtile_ld(const WTile& w, int tid, float4 (&v)[8], float (&gg)[8]) {
#pragma unroll
    for (int i = 0; i < 8; ++i) { const int k = (tid >> 6) + 8 * i, n4 = (tid & 63) * 4;
        v[i] = ldnt4(w.src + (size_t)(w.kt * 64 + k) * w.N + w.nt4 * 256 + n4); gg[i] = w.g ? w.g[w.kt * 64 + k] : 1.0f; }
}
DI void phase_weights(const Params& p, unsigned char* lds, int ti_lo, int ti_hi, int blk, int nblk) {
    const int tid = ltid(); float* t = (float*)lds;
    float4 v[8]; float gg[8];
    int ti = ti_lo + blk;
    if (ti < ti_hi) { const WTile w = wtile_of(p, ti); wtile_ld(w, tid, v, gg); }
    for (; ti < ti_hi; ti += nblk) {
        const WTile w = wtile_of(p, ti);
        __syncthreads();
#pragma unroll
        for (int i = 0; i < 8; ++i) { const int k = (tid >> 6) + 8 * i, n4 = (tid & 63) * 4;
            t[k * 257 + n4 + 0] = v[i].x * gg[i]; t[k * 257 + n4 + 1] = v[i].y * gg[i]; t[k * 257 + n4 + 2] = v[i].z * gg[i]; t[k * 257 + n4 + 3] = v[i].w * gg[i]; }
        if (ti + nblk < ti_hi) { const WTile wn = wtile_of(p, ti + nblk); wtile_ld(wn, tid, v, gg); }
        __syncthreads();
        { const int n = tid >> 1, k32 = (tid & 1) * 32; bf16_t* d = w.dst + (size_t)(w.nt4 * 256 + n) * DM + w.kt * 64 + k32;
#pragma unroll
          for (int q = 0; q < 4; ++q) { const float* c = t + (k32 + q * 8) * 257 + n; u32x4 o;
              o.x = pk2(c[0], c[257]); o.y = pk2(c[2 * 257], c[3 * 257]); o.z = pk2(c[4 * 257], c[5 * 257]); o.w = pk2(c[6 * 257], c[7 * 257]);
              *(u32x4*)(d + q * 8) = o; } }
    }
    __syncthreads();
}

DI void phase_norm0(const Params& p) {
    const int tid_ = ltid(), wid = tid_ >> 6, lane = tid_ & 63;
    bf16_t* xb = (bf16_t*)(p.ws + WS_XB); float* ssq = (float*)(p.ws + WS_SSQ);
    for (int i = blockIdx.x * NT + tid_; i < 2 * MT; i += gridDim.x * NT) ssq[MT + i] = 0.f;
    const int rstride = gridDim.x * 8;
    for (int row = blockIdx.x * 8 + wid; row < MT; row += 2 * rstride) {
        const int row2 = row + rstride; const bool two = row2 < MT; const int rb = two ? row2 : row;
        const float* sa = row < MP ? p.x_prompt + (size_t)row * DM : p.x_sample + (size_t)(row - MP) * DM;
        const float* sb = rb < MP ? p.x_prompt + (size_t)rb * DM : p.x_sample + (size_t)(rb - MP) * DM;
        float4 va[4], vb[4]; float ssa = 0.f, ssb = 0.f;
#pragma unroll
        for (int i = 0; i < 4; ++i) { va[i] = ldnt4(sa + i * 256 + lane * 4); vb[i] = ldnt4(sb + i * 256 + lane * 4); }
#pragma unroll
        for (int i = 0; i < 4; ++i) { ssa += va[i].x * va[i].x + va[i].y * va[i].y + va[i].z * va[i].z + va[i].w * va[i].w; ssb += vb[i].x * vb[i].x + vb[i].y * vb[i].y + vb[i].z * vb[i].z + vb[i].w * vb[i].w; }
        ssa = wave_sum(ssa); ssb = wave_sum(ssb);
        const float ra = rsqrtf(ssa * (1.0f / DM) + EPS), rb2 = rsqrtf(ssb * (1.0f / DM) + EPS);
#pragma unroll
        for (int i = 0; i < 4; ++i) { u32x2 w; w.x = pk2(va[i].x * ra, va[i].y * ra); w.y = pk2(va[i].z * ra, va[i].w * ra); *(u32x2*)(xb + (size_t)row * DM + i * 256 + lane * 4) = w;
            if (two) { u32x2 w2; w2.x = pk2(vb[i].x * rb2, vb[i].y * rb2); w2.y = pk2(vb[i].z * rb2, vb[i].w * rb2); *(u32x2*)(xb + (size_t)row2 * DM + i * 256 + lane * 4) = w2; } }
    }
}
DI void phase_final(const Params& p) {
    float* xs = p.out + O_Y; const float* ssq = (const float*)(p.ws + WS_SSQ) + 2 * MT;
    const int stride = gridDim.x * NT;
    for (int i0 = blockIdx.x * NT + ltid(); i0 < MT * 256; i0 += 8 * stride) {
        float4 v[8]; float r[8];
#pragma unroll
        for (int k = 0; k < 8; ++k) { const int idx = i0 + k * stride; if (idx < MT * 256) { v[k] = ldnt4(xs + (size_t)idx * 4); r[k] = ssq[idx >> 8]; } }
#pragma unroll
        for (int k = 0; k < 8; ++k) { const int idx = i0 + k * stride; if (idx < MT * 256) { const float rr = rsqrtf(r[k] * (1.0f / DM) + EPS);
            const float4 g = *(const float4*)(p.final_norm_g + (idx & 255) * 4); float4 o = v[k];
            o.x *= rr * g.x; o.y *= rr * g.y; o.z *= rr * g.z; o.w *= rr * g.w; stnt4(xs + (size_t)idx * 4, o); } }
    }
}

DI void phase_conv(const Params& p, int l, int row_lo, int row_hi, int blk, int nblk) {
    const bf16_t* z = (const bf16_t*)(p.ws + WS_Z); bf16_t* mix = (bf16_t*)(p.ws + WS_XB);
    const float* cw = p.conv_w + l * 3 * 256;
    for (int idx = row_lo * 32 + blk * NT + ltid(); idx < row_hi * 32; idx += nblk * NT) {
        const int row = idx >> 5, c = (idx & 31) * 8;
        int t, T; const float* buf; float* nc;
        if (row < MP) { const int b = row >> 11; t = row & 2047; T = 2048; buf = nullptr; nc = p.out + O_NCP + (size_t)(l * 8 + b) * 512; }
        else { const int rr = row - MP; const int b = rr >> 2; t = rr & 3; T = 4; buf = p.state_conv + (size_t)(l * 128 + b) * 512; nc = p.out + O_NCS + (size_t)(l * 128 + b) * 512; }
        float u[3][8];
#pragma unroll
        for (int j = 0; j < 3; ++j) {
            const int tp = t - 2 + j;
            if (tp >= 0) { const bf16_t* zr = z + (size_t)(row - 2 + j) * DIN + c; float ah[8], ac[8]; unpack8(*(const u32x4*)(zr + C_AH), ah); unpack8(*(const u32x4*)(zr + C_AC), ac);
#pragma unroll
                for (int i = 0; i < 8; ++i) u[j][i] = ah[i] * ac[i]; }
            else if (buf) { const float4 a = *(const float4*)(buf + (tp + 2) * 256 + c), b4 = *(const float4*)(buf + (tp + 2) * 256 + c + 4);
                u[j][0] = a.x; u[j][1] = a.y; u[j][2] = a.z; u[j][3] = a.w; u[j][4] = b4.x; u[j][5] = b4.y; u[j][6] = b4.z; u[j][7] = b4.w; }
            else {
#pragma unroll
                for (int i = 0; i < 8; ++i) u[j][i] = 0.f; }
        }
        const bf16_t* zr = z + (size_t)row * DIN + c; float ab[8], ag[8]; unpack8(*(const u32x4*)(zr + C_AB), ab); unpack8(*(const u32x4*)(zr + C_AG), ag);
        float w0[8], w1[8], w2[8];
        { const float4 a0 = *(const float4*)(cw + c), a1 = *(const float4*)(cw + c + 4), b0 = *(const float4*)(cw + 256 + c), b1 = *(const float4*)(cw + 256 + c + 4), c0 = *(const float4*)(cw + 512 + c), c1 = *(const float4*)(cw + 512 + c + 4);
          w0[0] = a0.x; w0[1] = a0.y; w0[2] = a0.z; w0[3] = a0.w; w0[4] = a1.x; w0[5] = a1.y; w0[6] = a1.z; w0[7] = a1.w;
          w1[0] = b0.x; w1[1] = b0.y; w1[2] = b0.z; w1[3] = b0.w; w1[4] = b1.x; w1[5] = b1.y; w1[6] = b1.z; w1[7] = b1.w;
          w2[0] = c0.x; w2[1] = c0.y; w2[2] = c0.z; w2[3] = c0.w; w2[4] = c1.x; w2[5] = c1.y; w2[6] = c1.z; w2[7] = c1.w; }
        float o[8];
#pragma unroll
        for (int i = 0; i < 8; ++i) { const float y = w0[i] * u[0][i] + w1[i] * u[1][i] + w2[i] * u[2][i]; o[i] = ab[i] * y * silu(ag[i]); }
        u32x4 w; w.x = pk2(o[0], o[1]); w.y = pk2(o[2], o[3]); w.z = pk2(o[4], o[5]); w.w = pk2(o[6], o[7]);
        *(u32x4*)(mix + (size_t)row * DM + c) = w;
        if (t >= T - 2) { float* d = nc + (t - (T - 2)) * 256 + c; *(float4*)d = make_float4(u[2][0], u[2][1], u[2][2], u[2][3]); *(float4*)(d + 4) = make_float4(u[2][4], u[2][5], u[2][6], u[2][7]); }
    }
}

DI void conv_ld(const bf16_t* z, int idx, u32x4 (&r)[8]) {
    const int row = idx >> 5, c = (idx & 31) * 8, t = row & 2047; const bf16_t* zr = z + (size_t)row * DIN + c;
#pragma unroll
    for (int j = 0; j < 3; ++j) { const bf16_t* q = zr - (size_t)((t - 2 + j >= 0) ? (2 - j) * DIN : 0); r[2 * j] = *(const u32x4*)(q + C_AH); r[2 * j + 1] = *(const u32x4*)(q + C_AC); }
    r[6] = *(const u32x4*)(zr + C_AB); r[7] = *(const u32x4*)(zr + C_AG);
}
DI void conv_fin(const Params& p, int l, int idx, const u32x4 (&r)[8]) {
    const int row = idx >> 5, c = (idx & 31) * 8, t = row & 2047; const float* cw = p.conv_w + l * 3 * 256;
    float u[3][8];
#pragma unroll
    for (int j = 0; j < 3; ++j) { float ah[8], ac[8]; unpack8(r[2 * j], ah); unpack8(r[2 * j + 1], ac); const float m = (t - 2 + j >= 0) ? 1.f : 0.f;
#pragma unroll
        for (int i = 0; i < 8; ++i) u[j][i] = ah[i] * ac[i] * m; }
    float ab[8], ag[8]; unpack8(r[6], ab); unpack8(r[7], ag);
    float w0[8], w1[8], w2[8];
    { const float4 a0 = *(const float4*)(cw + c), a1 = *(const float4*)(cw + c + 4), b0 = *(const float4*)(cw + 256 + c), b1 = *(const float4*)(cw + 256 + c + 4), c0 = *(const float4*)(cw + 512 + c), c1 = *(const float4*)(cw + 512 + c + 4);
      w0[0] = a0.x; w0[1] = a0.y; w0[2] = a0.z; w0[3] = a0.w; w0[4] = a1.x; w0[5] = a1.y; w0[6] = a1.z; w0[7] = a1.w;
      w1[0] = b0.x; w1[1] = b0.y; w1[2] = b0.z; w1[3] = b0.w; w1[4] = b1.x; w1[5] = b1.y; w1[6] = b1.z; w1[7] = b1.w;
      w2[0] = c0.x; w2[1] = c0.y; w2[2] = c0.z; w2[3] = c0.w; w2[4] = c1.x; w2[5] = c1.y; w2[6] = c1.z; w2[7] = c1.w; }
    float o[8];
#pragma unroll
    for (int i = 0; i < 8; ++i) { const float y = w0[i] * u[0][i] + w1[i] * u[1][i] + w2[i] * u[2][i]; o[i] = ab[i] * y * silu(ag[i]); }
    u32x4 w; w.x = pk2(o[0], o[1]); w.y = pk2(o[2], o[3]); w.z = pk2(o[4], o[5]); w.w = pk2(o[6], o[7]);
    *(u32x4*)((bf16_t*)(p.ws + WS_XB) + (size_t)row * DM + c) = w;
    if (t >= 2046) { float* d = p.out + O_NCP + (size_t)(l * 8 + (row >> 11)) * 512 + (t - 2046) * 256 + c; *(float4*)d = make_float4(u[2][0], u[2][1], u[2][2], u[2][3]); *(float4*)(d + 4) = make_float4(u[2][4], u[2][5], u[2][6], u[2][7]); }
}
DI void phase_conv_prompt(const Params& p, int l, int idx_lo, int idx_hi, int stride) {
    const bf16_t* z = (const bf16_t*)(p.ws + WS_Z);
    for (int idx = idx_lo + ltid(); idx < idx_hi; idx += 2 * stride) {
        u32x4 ra[8], rb[8]; const bool two = idx + stride < idx_hi;
        conv_ld(z, idx, ra); conv_ld(z, two ? idx + stride : idx, rb);
        conv_fin(p, l, idx, ra); if (two) conv_fin(p, l, idx + stride, rb);
    }
}

DI void pool_ld(const bf16_t* z, int tile, int tid, u32x4 (&vld)[3], u32x4 (&gld)[2]) {
    const int row0 = tile * 32, t0 = row0 & 2047;
#pragma unroll
    for (int k = 0; k < 3; ++k) { const int it = tid + k * NT, rr = it >> 5, c = (it & 31) * 8; vld[k] = (u32x4){0u, 0u, 0u, 0u};
        if (it < 47 * 32 && t0 - 15 + rr >= 0) vld[k] = *(const u32x4*)(z + (size_t)(row0 - 15 + rr) * DIN + C_PV + c); }
#pragma unroll
    for (int k = 0; k < 2; ++k) { const int it = tid + k * NT, tl = it >> 5, c = (it & 31) * 8; gld[k] = *(const u32x4*)(z + (size_t)(row0 + tl) * DIN + C_PG + c); }
}
DI void phase_pool(const Params& p, int l, unsigned char* lds, int tile_lo, int tile_hi, int blk, int nblk, bool do_bufs, bool setup = true) {
    const int tid = ltid(), wid = tid >> 6, lane = tid & 63, lr = lane & 15, lq = lane >> 4;
    const bf16_t* z = (const bf16_t*)(p.ws + WS_Z); bf16_t* mix = (bf16_t*)(p.ws + WS_XB);
    constexpr int P_PWT = 0, P_UB = 36864, P_GT = 53760, P_OB = 87040, P_VT = 103936;
    float* gt = (float*)(lds + P_GT);
    __syncthreads();
    if (setup) { const float* pw = p.pool_w + (size_t)l * 16384;
      for (int i = tid; i < 16384; i += NT) { const int g = i >> 12, c = (i >> 6) & 63, d = i & 63; *(bf16_t*)(lds + P_PWT + (g * 64 + d) * 144 + c * 2) = f2bf(pw[i]); } }
    u32x4 vld[3], gld[2];
    if (tile_lo + blk < tile_hi && tile_lo + blk < 512) pool_ld(z, tile_lo + blk, tid, vld, gld);
    for (int tile = tile_lo + blk; tile < tile_hi; tile += nblk) {
        __syncthreads();
        if (tile < 512) {
            const int row0 = tile * 32, t0 = row0 & 2047;
#pragma unroll
            for (int k = 0; k < 3; ++k) { const int it = tid + k * NT, rr = it >> 5, c = (it & 31) * 8; if (it < 47 * 32) *(u32x4*)(lds + P_VT + rr * 528 + c * 2) = vld[k]; }
#pragma unroll
            for (int k = 0; k < 2; ++k) { const int it = tid + k * NT, tl = it >> 5, c = (it & 31) * 8;
                float g[8]; unpack8(gld[k], g);
                const float4 s0 = *(const float4*)(p.pool_scale + l * 256 + c), s1 = *(const float4*)(p.pool_scale + l * 256 + c + 4);
                *(float4*)(gt + tl * 260 + c) = make_float4(s0.x * silu(g[0]), s0.y * silu(g[1]), s0.z * silu(g[2]), s0.w * silu(g[3]));
                *(float4*)(gt + tl * 260 + c + 4) = make_float4(s1.x * silu(g[4]), s1.y * silu(g[5]), s1.z * silu(g[6]), s1.w * silu(g[7])); }
            if (tile + nblk < tile_hi && tile + nblk < 512) pool_ld(z, tile + nblk, tid, vld, gld);
            __syncthreads();
#pragma unroll
            for (int k = 0; k < 2; ++k) { const int it = tid + k * NT, tl = it >> 5, c = (it & 31) * 8, gi = c >> 6, w = 2 << gi;
                float s[8], cur[8];
                unpack8(*(const u32x4*)(lds + P_VT + (tl + 15) * 528 + c * 2), cur);
#pragma unroll
                for (int i = 0; i < 8; ++i) s[i] = cur[i];
                for (int j = 1; j < w; ++j) { float v[8]; unpack8(*(const u32x4*)(lds + P_VT + (tl + 15 - j) * 528 + c * 2), v);
#pragma unroll
                    for (int i = 0; i < 8; ++i) s[i] += v[i]; }
                const float inv = frcp((float)min(w, t0 + tl + 1));
                u32x4 uw; uw.x = pk2(s[0] * inv - cur[0], s[1] * inv - cur[1]); uw.y = pk2(s[2] * inv - cur[2], s[3] * inv - cur[3]);
                uw.z = pk2(s[4] * inv - cur[4], s[5] * inv - cur[5]); uw.w = pk2(s[6] * inv - cur[6], s[7] * inv - cur[7]);
                *(u32x4*)(lds + P_UB + tl * 528 + c * 2) = uw; }
        } else {
            for (int it = tid; it < 1024; it += NT) {
                const int tl = it >> 5, c = (it & 31) * 8, gi = c >> 6, w = 2 << gi;
                const int row = MP + (tile - 512) * 32 + tl, rr = row - MP, t = rr & 3; const float* buf = p.state_pool + (size_t)(l * 128 + (rr >> 2)) * 15 * 256;
                float s[8], cur[8];
                unpack8(*(const u32x4*)(z + (size_t)row * DIN + C_PV + c), cur);
#pragma unroll
                for (int i = 0; i < 8; ++i) s[i] = cur[i];
#pragma unroll
                for (int j = 1; j < 4; ++j) { float v[8]; unpack8(*(const u32x4*)(z + (size_t)(row - min(j, t)) * DIN + C_PV + c), v); const float m = (j <= t && j < w) ? 1.f : 0.f;
#pragma unroll
                    for (int i = 0; i < 8; ++i) s[i] += m * v[i]; }
#pragma unroll
                for (int j = 1; j < 16; ++j) { const int tp = t - j, bi = tp < 0 ? 15 + tp : 0; const float m = (tp < 0 && j < w) ? 1.f : 0.f;
                    const float4 a = *(const float4*)(buf + bi * 256 + c), b4 = *(const float4*)(buf + bi * 256 + c + 4);
                    s[0] += m * a.x; s[1] += m * a.y; s[2] += m * a.z; s[3] += m * a.w; s[4] += m * b4.x; s[5] += m * b4.y; s[6] += m * b4.z; s[7] += m * b4.w; }
                const float inv = frcp((float)w);
                u32x4 uw; uw.x = pk2(s[0] * inv - cur[0], s[1] * inv - cur[1]); uw.y = pk2(s[2] * inv - cur[2], s[3] * inv - cur[3]);
                uw.z = pk2(s[4] * inv - cur[4], s[5] * inv - cur[5]); uw.w = pk2(s[6] * inv - cur[6], s[7] * inv - cur[7]);
                *(u32x4*)(lds + P_UB + tl * 528 + c * 2) = uw;
                float g[8]; unpack8(*(const u32x4*)(z + (size_t)row * DIN + C_PG + c), g);
                const float4 s0 = *(const float4*)(p.pool_scale + l * 256 + c), s1 = *(const float4*)(p.pool_scale + l * 256 + c + 4);
                *(float4*)(gt + tl * 260 + c) = make_float4(s0.x * silu(g[0]), s0.y * silu(g[1]), s0.z * silu(g[2]), s0.w * silu(g[3]));
                *(float4*)(gt + tl * 260 + c + 4) = make_float4(s1.x * silu(g[4]), s1.y * silu(g[5]), s1.z * silu(g[6]), s1.w * silu(g[7]));
            }
        }
        __syncthreads();
        { const int gi = wid >> 1, tt = wid & 1;
          f32x4 acc[4];
#pragma unroll
          for (int n = 0; n < 4; ++n) acc[n] = (f32x4){0.f, 0.f, 0.f, 0.f};
#pragma unroll
          for (int ks = 0; ks < 2; ++ks) { const bf16x8 a = *(const bf16x8*)(lds + P_UB + (tt * 16 + lr) * 528 + (gi * 64 + ks * 32 + lq * 8) * 2);
#pragma unroll
              for (int n = 0; n < 4; ++n) { const bf16x8 bb = *(const bf16x8*)(lds + P_PWT + (gi * 64 + n * 16 + lr) * 144 + (ks * 32 + lq * 8) * 2);
                  acc[n] = __builtin_amdgcn_mfma_f32_16x16x32_bf16(a, bb, acc[n], 0, 0, 0); } }
#pragma unroll
          for (int n = 0; n < 4; ++n)
#pragma unroll
              for (int j = 0; j < 4; ++j) { const int t = tt * 16 + lq * 4 + j, ch = gi * 64 + n * 16 + lr;
                  *(bf16_t*)(lds + P_OB + t * 528 + ch * 2) = f2bf(acc[n][j] * gt[t * 260 + ch]); } }
        __syncthreads();
        for (int it = tid; it < 1024; it += NT) { const int tl = it >> 5, c = (it & 31) * 8;
            const int row = tile < 512 ? tile * 32 + tl : MP + (tile - 512) * 32 + tl;
            *(u32x4*)(mix + (size_t)row * DM + 768 + c) = *(const u32x4*)(lds + P_OB + tl * 528 + c * 2); }
    }
    if (do_bufs)
    for (int idx = blk * NT + tid; idx < 136 * 15 * 32; idx += nblk * NT) {
        const int c = (idx & 31) * 8, r = idx >> 5, j = r % 15, bg = r / 15;
        float v[8]; float* dst;
        if (bg < 8) { unpack8(*(const u32x4*)(z + (size_t)(bg * 2048 + 2048 - 15 + j) * DIN + C_PV + c), v); dst = p.out + O_NPP + (size_t)((l * 8 + bg) * 15 + j) * 256 + c; }
        else { const int b = bg - 8, tp = j - 11; dst = p.out + O_NPS + (size_t)((l * 128 + b) * 15 + j) * 256 + c;
            if (tp < 0) { const float* sp = p.state_pool + (size_t)((l * 128 + b) * 15 + j + 4) * 256 + c; const float4 a = *(const float4*)sp, b4 = *(const float4*)(sp + 4);
                v[0] = a.x; v[1] = a.y; v[2] = a.z; v[3] = a.w; v[4] = b4.x; v[5] = b4.y; v[6] = b4.z; v[7] = b4.w; }
            else unpack8(*(const u32x4*)(z + (size_t)(MP + b * 4 + tp) * DIN + C_PV + c), v); }
        *(float4*)dst = make_float4(v[0], v[1], v[2], v[3]); *(float4*)(dst + 4) = make_float4(v[4], v[5], v[6], v[7]);
    }
    __syncthreads();
}

DI float lb_of(const Params& p, int l, int d) {
    if (l == 0) return 0.f;
    const float a0 = p.hgrn_lb[d], a1 = p.hgrn_lb[512 + d];
    return frcp(1.0f + __expf(a0 - a1));
}
DI void gate_fk(float x, float lb, float& f, float& k) {
    x = fminf(fmaxf(x, -30.f), 30.f);
    const float e = __expf(-x), sig = frcp(1.0f + e);
    f = lb + (1.0f - lb) * sig; k = (1.0f - lb) * (e * sig);
}

struct ChunkRaw { unsigned f[8], v[8], q[8]; u32x4 qm[2], km[2]; bf16x8 bS[4]; u32x2 g[4]; };
template <bool PASSC>
DI void chunk_load(ChunkRaw& r, const Params& p, int ch, int tid) {
    const int dp = tid & 63, wid = tid >> 6, lane = tid & 63, lr = lane & 15, lq = lane >> 4;
    const int b = ch >> 7, h = (ch >> 5) & 3, c = ch & 31, r0 = b * 2048 + c * 64;
    const bf16_t* z = (const bf16_t*)(p.ws + WS_Z);
    const bf16_t* S16 = (const bf16_t*)(p.ws + WS_U + 33554432) + (size_t)ch * 16384;
    const bf16_t* zrow = z + (size_t)(r0 + wid * 8) * DIN + h * 128 + 2 * dp;
    if (!PASSC) {
#pragma unroll
        for (int i = 0; i < 8; ++i) r.f[i] = *(const unsigned*)(zrow + (size_t)i * DIN + C_F);
#pragma unroll
        for (int i = 0; i < 8; ++i) r.q[i] = *(const unsigned*)(zrow + (size_t)i * DIN + C_Q);
    } else {
#pragma unroll
        for (int k = 0; k < 2; ++k) { const int u = tid + k * NT; const bf16_t* zr = z + (size_t)(r0 + (u >> 4)) * DIN + h * 128 + (u & 15) * 8;
            r.qm[k] = *(const u32x4*)(zr + C_Q); r.km[k] = *(const u32x4*)(zr + C_F); }
    }
#pragma unroll
    for (int i = 0; i < 8; ++i) r.v[i] = *(const unsigned*)(zrow + (size_t)i * DIN + C_I);
    if (PASSC) {
#pragma unroll
        for (int ks = 0; ks < 4; ++ks) r.bS[ks] = *(const bf16x8*)(S16 + (size_t)(wid * 16 + lr) * 128 + ks * 32 + lq * 8);
#pragma unroll
        for (int tt = 0; tt < 4; ++tt) r.g[tt] = *(const u32x2*)(z + (size_t)(r0 + tt * 16 + lr) * DIN + C_GB + h * 128 + wid * 16 + lq * 4);
    }
}
template <bool PASSC>
DI void hgrn_chunk(const ChunkRaw& raw, const Params& p, int l, int ch, unsigned char* lds, int tid) {
    const int dp = tid & 63, wid = tid >> 6, lane = tid & 63, lr = lane & 15, lq = lane >> 4, d0 = 2 * dp;
    const int b = ch >> 7, h = (ch >> 5) & 3, c = ch & 31, r0 = b * 2048 + c * 64;
    bf16_t* U16 = (bf16_t*)(p.ws + WS_U) + (size_t)ch * 16384;
    float* tot = (float*)(lds + L_TOT); float* eb = (float*)(lds + L_EB);
    const float lb0 = lb_of(p, l, h * 128 + d0), lb1 = lb_of(p, l, h * 128 + d0 + 1);
    const bf16x8 (&bS)[4] = raw.bS; const u32x2 (&graw)[4] = raw.g;
    float cs0[8], cs1[8], kk0[8], kk1[8]; float off0 = 0.f, off1 = 0.f, bref0 = 0.f, bref1 = 0.f, bL0 = 0.f, bL1 = 0.f;
    if (!PASSC) {
        float cum0 = 0.f, cum1 = 0.f;
#pragma unroll
        for (int i = 0; i < 8; ++i) { float f, k; gate_fk(__uint_as_float(raw.f[i] << 16), lb0, f, k); cum0 += __logf(f); cs0[i] = cum0; kk0[i] = k;
            gate_fk(__uint_as_float(raw.f[i] & 0xffff0000u), lb1, f, k); cum1 += __logf(f); cs1[i] = cum1; kk1[i] = k; }
        *(float2*)(tot + wid * 128 + d0) = make_float2(cum0, cum1);
        __syncthreads();
#pragma unroll
        for (int sgm = 0; sgm < 8; ++sgm) { const float2 tv = *(const float2*)(tot + sgm * 128 + d0);
            if (sgm < wid) { off0 += tv.x; off1 += tv.y; } if (sgm < 4) { bref0 += tv.x; bref1 += tv.y; } bL0 += tv.x; bL1 += tv.y; }
    }
    { u32x4 w0, w1;
#pragma unroll
      for (int j = 0; j < 4; ++j) { w0[j] = (raw.v[2 * j] & 0xffffu) | (raw.v[2 * j + 1] << 16); w1[j] = (raw.v[2 * j] >> 16) | (raw.v[2 * j + 1] & 0xffff0000u); }
      *(u32x4*)(lds + L_VT + d0 * 144 + wid * 16) = w0; *(u32x4*)(lds + L_VT + (d0 + 1) * 144 + wid * 16) = w1; }
    if (!PASSC) {
        float km0[8], km1[8];
        { bf16_t* zw = (bf16_t*)(p.ws + WS_Z) + (size_t)(r0 + wid * 8) * DIN + h * 128 + d0;
#pragma unroll
          for (int i = 0; i < 8; ++i) { const float b0 = fminf(fmaxf(off0 + cs0[i] - bref0, -80.f), 80.f), b1 = fminf(fmaxf(off1 + cs1[i] - bref1, -80.f), 80.f); const float e0 = __expf(b0), e1 = __expf(b1);
              km0[i] = kk0[i] * frcp(e0); km1[i] = kk1[i] * frcp(e1);
              *(unsigned*)(zw + (size_t)i * DIN + C_Q) = pk2(__uint_as_float(raw.q[i] << 16) * e0, __uint_as_float(raw.q[i] & 0xffff0000u) * e1);
              *(unsigned*)(zw + (size_t)i * DIN + C_F) = pk2(km0[i], km1[i]); } }
        u32x4 w0, w1;
#pragma unroll
        for (int j = 0; j < 4; ++j) { w0[j] = pk2(km0[2 * j], km0[2 * j + 1]); w1[j] = pk2(km1[2 * j], km1[2 * j + 1]); }
        *(u32x4*)(lds + L_ST + d0 * 144 + wid * 16) = w0; *(u32x4*)(lds + L_ST + (d0 + 1) * 144 + wid * 16) = w1;
        if (wid == 0) { *(float2*)((float*)(p.ws + WS_DEC) + (size_t)ch * 128 + d0) = make_float2(__expf(bL0), __expf(bL1));
            *(float2*)((float*)(p.ws + WS_EBR) + (size_t)ch * 128 + d0) = make_float2(__expf(bref0), __expf(bref1));
            *(float2*)(eb + d0) = make_float2(__expf(bL0 - bref0), __expf(bL1 - bref1)); }
        __syncthreads();
        f32x4 acc[8];
#pragma unroll
        for (int n = 0; n < 8; ++n) acc[n] = (f32x4){0.f, 0.f, 0.f, 0.f};
#pragma unroll
        for (int ks = 0; ks < 2; ++ks) {
            const bf16x8 bv = *(const bf16x8*)(lds + L_VT + (wid * 16 + lr) * 144 + (ks * 32 + lq * 8) * 2);
#pragma unroll
            for (int n = 0; n < 8; ++n) { const bf16x8 ak = *(const bf16x8*)(lds + L_ST + (n * 16 + lr) * 144 + (ks * 32 + lq * 8) * 2);
                acc[n] = __builtin_amdgcn_mfma_f32_16x16x32_bf16(ak, bv, acc[n], 0, 0, 0); }
        }
#pragma unroll
        for (int n = 0; n < 8; ++n) { const float4 sc = *(const float4*)(eb + n * 16 + lq * 4);
            u32x2 w2; w2.x = pk2(acc[n][0] * sc.x, acc[n][1] * sc.y); w2.y = pk2(acc[n][2] * sc.z, acc[n][3] * sc.w);
            *(u32x2*)(U16 + (size_t)(wid * 16 + lr) * 128 + n * 16 + lq * 4) = w2; }
        __syncthreads();
    } else {
#pragma unroll
        for (int k = 0; k < 2; ++k) { const int u = tid + k * NT; *(u32x4*)(lds + L_QM + (u >> 4) * 272 + (u & 15) * 16) = raw.qm[k]; *(u32x4*)(lds + L_KM + (u >> 4) * 272 + (u & 15) * 16) = raw.km[k]; }
        __syncthreads();
        { const int tt = wid >> 1;
#pragma unroll
          for (int jj = 0; jj < 2; ++jj) {
            const int st = (wid & 1) * 2 + jj; f32x4 acc = (f32x4){0.f, 0.f, 0.f, 0.f};
            if (st <= tt) {
#pragma unroll
                for (int ks = 0; ks < 4; ++ks) { const bf16x8 a = *(const bf16x8*)(lds + L_QM + (tt * 16 + lr) * 272 + (ks * 32 + lq * 8) * 2);
                    const bf16x8 bb = *(const bf16x8*)(lds + L_KM + (st * 16 + lr) * 272 + (ks * 32 + lq * 8) * 2);
                    acc = __builtin_amdgcn_mfma_f32_16x16x32_bf16(a, bb, acc, 0, 0, 0); }
            }
#pragma unroll
            for (int j = 0; j < 4; ++j) { const int t = tt * 16 + lq * 4 + j, s = st * 16 + lr;
                *(bf16_t*)(lds + L_AM + t * 144 + s * 2) = f2bf(s <= t ? acc[j] : 0.f); }
          } }
        __syncthreads();
        f32x4 acc[4];
        bf16x8 bV[2];
#pragma unroll
        for (int ks = 0; ks < 2; ++ks) bV[ks] = *(const bf16x8*)(lds + L_VT + (wid * 16 + lr) * 144 + (ks * 32 + lq * 8) * 2);
#pragma unroll
        for (int tt = 0; tt < 4; ++tt) {
            acc[tt] = (f32x4){0.f, 0.f, 0.f, 0.f};
#pragma unroll
            for (int ks = 0; ks < 4; ++ks) { const bf16x8 q = *(const bf16x8*)(lds + L_QM + (tt * 16 + lr) * 272 + (ks * 32 + lq * 8) * 2);
                acc[tt] = __builtin_amdgcn_mfma_f32_16x16x32_bf16(bS[ks], q, acc[tt], 0, 0, 0); }
#pragma unroll
            for (int ks = 0; ks < 2; ++ks) { if (ks * 32 <= tt * 16 + 15) { const bf16x8 am = *(const bf16x8*)(lds + L_AM + (tt * 16 + lr) * 144 + (ks * 32 + lq * 8) * 2);
                acc[tt] = __builtin_amdgcn_mfma_f32_16x16x32_bf16(bV[ks], am, acc[tt], 0, 0, 0); } }
        }
        float* ssq = (float*)(lds + L_ST);
#pragma unroll
        for (int tt = 0; tt < 4; ++tt) { float ss = acc[tt][0] * acc[tt][0] + acc[tt][1] * acc[tt][1] + acc[tt][2] * acc[tt][2] + acc[tt][3] * acc[tt][3];
            ss += __shfl_xor(ss, 16, 64); ss += __shfl_xor(ss, 32, 64);
            if (lq == 0) ssq[(tt * 16 + lr) * 8 + wid] = ss; }
        __syncthreads();
        bf16_t* mix = (bf16_t*)(p.ws + WS_XB);
        const float4 ng = *(const float4*)(p.hgrn_norm_g + l * 512 + h * 128 + wid * 16 + lq * 4);
#pragma unroll
        for (int tt = 0; tt < 4; ++tt) { const int t = tt * 16 + lr;
            const float4 s0 = *(const float4*)(ssq + t * 8), s1 = *(const float4*)(ssq + t * 8 + 4);
            const float rs = rsqrtf((s0.x + s0.y + s0.z + s0.w + s1.x + s1.y + s1.z + s1.w) * (1.0f / 128.0f) + EPS);
            const float g0 = __uint_as_float(graw[tt].x << 16), g1 = __uint_as_float(graw[tt].x & 0xffff0000u), g2 = __uint_as_float(graw[tt].y << 16), g3 = __uint_as_float(graw[tt].y & 0xffff0000u);
            u32x2 w2; w2.x = pk2(acc[tt][0] * rs * ng.x * silu(g0), acc[tt][1] * rs * ng.y * silu(g1)); w2.y = pk2(acc[tt][2] * rs * ng.z * silu(g2), acc[tt][3] * rs * ng.w * silu(g3));
            *(u32x2*)(mix + (size_t)(r0 + t) * DM + 256 + h * 128 + wid * 16 + lq * 4) = w2; }
        __syncthreads();
    }
}

template <bool PASSC>
DI void hgrn_pass(const Params& p, int l, unsigned char* lds) {
    const int tid = ltid();
    if (PASSC_PREFETCH || !PASSC) {
        ChunkRaw ra, rb;
        chunk_load<PASSC>(ra, p, (int)blockIdx.x, tid);
        chunk_load<PASSC>(rb, p, (int)blockIdx.x + GRID, tid);
        hgrn_chunk<PASSC>(ra, p, l, (int)blockIdx.x, lds, tid);
        chunk_load<PASSC>(ra, p, (int)blockIdx.x + 2 * GRID, tid);
        hgrn_chunk<PASSC>(rb, p, l, (int)blockIdx.x + GRID, lds, tid);
        chunk_load<PASSC>(rb, p, (int)blockIdx.x + 3 * GRID, tid);
        hgrn_chunk<PASSC>(ra, p, l, (int)blockIdx.x + 2 * GRID, lds, tid);
        hgrn_chunk<PASSC>(rb, p, l, (int)blockIdx.x + 3 * GRID, lds, tid);
    } else {
        for (int k = 0; k < 4; ++k) { ChunkRaw ra; chunk_load<PASSC>(ra, p, (int)blockIdx.x + k * GRID, tid); hgrn_chunk<PASSC>(ra, p, l, (int)blockIdx.x + k * GRID, lds, tid); }
    }
}

DI void phase_scan(const Params& p, int l, int idx_lo, int idx_hi, int stride) {
    const bf16_t* U16 = (const bf16_t*)(p.ws + WS_U); bf16_t* S16 = (bf16_t*)(p.ws + WS_U + 33554432);
    const float* dec = (const float*)(p.ws + WS_DEC); const float* ebr = (const float*)(p.ws + WS_EBR);
    for (int idx = idx_lo + ltid(); idx < idx_hi; idx += stride) {
        const int d4 = (idx & 31) * 4, e = (idx >> 5) & 127, bh = idx >> 12;
        float4 s = make_float4(0.f, 0.f, 0.f, 0.f);
        const size_t o0 = (size_t)bh * 32 * 16384 + e * 128 + d4; const float* pd0 = dec + (size_t)bh * 32 * 128 + d4; const float* pe0 = ebr + (size_t)bh * 32 * 128 + d4;
        for (int cb = 0; cb < 32; cb += 8) {
            u32x2 u[8]; float4 dc[8], ee[8];
#pragma unroll
            for (int j = 0; j < 8; ++j) { u[j] = *(const u32x2*)(U16 + o0 + (size_t)(cb + j) * 16384); dc[j] = *(const float4*)(pd0 + (cb + j) * 128); ee[j] = *(const float4*)(pe0 + (cb + j) * 128); }
#pragma unroll
            for (int j = 0; j < 8; ++j) { u32x2 w2; w2.x = pk2(s.x * ee[j].x, s.y * ee[j].y); w2.y = pk2(s.z * ee[j].z, s.w * ee[j].w);
                *(u32x2*)(S16 + o0 + (size_t)(cb + j) * 16384) = w2;
                s.x = dc[j].x * s.x + __uint_as_float(u[j].x << 16); s.y = dc[j].y * s.y + __uint_as_float(u[j].x & 0xffff0000u);
                s.z = dc[j].z * s.z + __uint_as_float(u[j].y << 16); s.w = dc[j].w * s.w + __uint_as_float(u[j].y & 0xffff0000u); }
        }
        float* o = p.out + O_NHP + (size_t)(l * 32 + bh) * 16384 + e;
        o[(d4 + 0) * 128] = s.x; o[(d4 + 1) * 128] = s.y; o[(d4 + 2) * 128] = s.z; o[(d4 + 3) * 128] = s.w;
    }
}

DI void sample_ld(const Params& p, int l, int item, int tid, float4 (&S)[8], bf16_t (&zs)[5]) {
    const int b = item >> 2, h = item & 3, e4 = (tid & 31) * 4, dg = tid >> 5;
    const float* S0 = p.state_hgrn + (size_t)((l * 128 + b) * 4 + h) * 16384;
    { const bf16_t* zr = (const bf16_t*)(p.ws + WS_Z) + (size_t)(MP + b * 4 + (tid >> 7)) * DIN + h * 128 + (tid & 127); zs[0] = zr[C_F]; zs[1] = zr[C_Q]; zs[2] = zr[C_I]; zs[3] = zr[C_GB]; zs[4] = 0; }
#pragma unroll
    for (int i = 0; i < 8; ++i) S[i] = ldnt4(S0 + (size_t)(dg + 16 * i) * 128 + e4);
}
DI void hgrn_sample(const Params& p, int l, int item, unsigned char* lds, int tid, float4 (&S)[8], const bf16_t (&zs)[5]) {
    const int b = item >> 2, h = item & 3, wid = tid >> 6, lane = tid & 63;
    const bf16_t* z = (const bf16_t*)(p.ws + WS_Z);
    float* sf = (float*)lds; float* sk = sf + 512; float* sq = sk + 512; float* sv = sq + 512; float* sg = sv + 512; float* red = sg + 512; float* ssq = red + 8192;
    { const int d = tid & 127;
      float f, k; gate_fk(bf2f(zs[0]), lb_of(p, l, h * 128 + d), f, k);
      sf[tid] = f; sk[tid] = k; sq[tid] = bf2f(zs[1]); sv[tid] = bf2f(zs[2]); sg[tid] = bf2f(zs[3]); }
    const int e4 = (tid & 31) * 4, dg = tid >> 5;
    float* S1 = p.out + O_NHS + (size_t)((l * 128 + b) * 4 + h) * 16384;
    __syncthreads();
#pragma unroll
    for (int t = 0; t < 4; ++t) {
        const float4 v = *(const float4*)(sv + t * 128 + e4); float4 a = make_float4(0.f, 0.f, 0.f, 0.f);
#pragma unroll
        for (int i = 0; i < 8; ++i) { const int d = t * 128 + dg + 16 * i; const float f = sf[d], k = sk[d], q = sq[d];
            S[i].x = f * S[i].x + k * v.x; S[i].y = f * S[i].y + k * v.y; S[i].z = f * S[i].z + k * v.z; S[i].w = f * S[i].w + k * v.w;
            a.x += q * S[i].x; a.y += q * S[i].y; a.z += q * S[i].z; a.w += q * S[i].w; }
        *(float4*)(red + (t * 16 + dg) * 128 + e4) = a;
    }
#pragma unroll
    for (int i = 0; i < 8; ++i) stnt4(S1 + (size_t)(dg + 16 * i) * 128 + e4, S[i]);
    __syncthreads();
    { const int t = tid >> 7, e = tid & 127; float o = 0.f;
#pragma unroll
      for (int g = 0; g < 16; ++g) o += red[(t * 16 + g) * 128 + e];
      const float ss = wave_sum(o * o);
      if (lane == 0) ssq[wid] = ss;
      __syncthreads();
      const float rs = rsqrtf((ssq[2 * t] + ssq[2 * t + 1]) * (1.0f / 128.0f) + EPS);
      ((bf16_t*)(p.ws + WS_XB))[(size_t)(MP + b * 4 + t) * DM + 256 + h * 128 + e] = f2bf(o * rs * p.hgrn_norm_g[l * 512 + h * 128 + e] * silu(sg[tid])); }
    __syncthreads();
}
DI void phase_sample(const Params& p, int l, unsigned char* lds) {
    const int tid = ltid(), bk = (int)blockIdx.x; float4 Sa[8], Sb[8]; bf16_t za[5], zb[5];
    sample_ld(p, l, bk, tid, Sa, za);
    if (bk >= 16) sample_ld(p, l, bk + GRID, tid, Sb, zb);
    hgrn_sample(p, l, bk, lds, tid, Sa, za);
    if (bk >= 32 && bk < 48) sample_ld(p, l, bk - 32 + GRID, tid, Sa, za);
    if (bk >= 16) hgrn_sample(p, l, bk + GRID, lds, tid, Sb, zb);
    if (bk >= 32 && bk < 48) hgrn_sample(p, l, bk - 32 + GRID, lds, tid, Sa, za);
}

DI Params load_params() {
    Params p{};
#if defined(__HIP_DEVICE_COMPILE__)
    typedef const __attribute__((address_space(4))) Params* KParams;
    KParams kp = (KParams)__builtin_amdgcn_kernarg_segment_ptr(); asm volatile("" : "+s"(kp));
    p.x_prompt = kp->x_prompt; p.x_sample = kp->x_sample; p.state_conv = kp->state_conv; p.state_hgrn = kp->state_hgrn; p.state_pool = kp->state_pool; p.norm_g = kp->norm_g; p.w_in = kp->w_in;
    p.conv_w = kp->conv_w; p.hgrn_lb = kp->hgrn_lb; p.hgrn_norm_g = kp->hgrn_norm_g; p.pool_w = kp->pool_w; p.pool_scale = kp->pool_scale; p.w_out = kp->w_out; p.final_norm_g = kp->final_norm_g;
    p.out = kp->out; p.ws = kp->ws;
#endif
    return p;
}
#define LP() load_params()
__global__ __launch_bounds__(512, 2) void hymba_fwd(Params p_unused) {
    extern __shared__ __attribute__((aligned(16))) unsigned char shm[];
    cg::grid_group grid = cg::this_grid();
    volatile LAS unsigned* xst = (volatile LAS unsigned*)(shm + 131072);
    if (threadIdx.x == 0) { xst[0] = 0u; xst[1] = 0u; xst[2] = 0u; xst[3] = 0u; }
    __syncthreads();
    { const Params p = LP(); (void)xcd_barrier_post((unsigned*)(p.ws + WS_BAR), xst); }
#define GSYNC() do { const Params p_ = LP(); XcdBarrier b_; b_.bar = (unsigned*)(p_.ws + WS_BAR); b_.x = xb_xcc_id(); b_.st = xst; xcd_barrier(b_); } while (0)
    { const Params p = LP(); phase_weights(p, shm, 0, 224, (int)blockIdx.x, (int)gridDim.x); }
    { const Params p = LP(); phase_norm0(p); }
    { const Params p = LP(); if (p.ws == nullptr) grid.sync(); }
    GSYNC();
    for (int l = 0; l < 2; ++l) {
        { const Params p = LP(); pg8::Gemm g; g.A = (const bf16_t*)(p.ws + (l == 0 ? WS_XB : WS_U)); g.Bt = (const bf16_t*)(p.ws + WS_WIN) + (size_t)l * DIN * DM; g.M = MT; g.N = DIN; g.K = DM;
          pg8::StaticOrder S; S.init(MT, DIN, (int)gridDim.x, (int)blockIdx.x); EpiZ E; E.O = (bf16_t*)(p.ws + WS_Z); E.ssq = l == 0 ? nullptr : (const float*)(p.ws + WS_SSQ) + (size_t)l * MT;
          pg8::gemm_phase<EpiZ, pg8::StaticOrder, false>((PG8_LAS unsigned char*)shm, g, S, E, nullptr);
        }
        if (blockIdx.x >= 156) { const Params p = LP(); phase_weights(p, shm, l == 0 ? 224 : 512, l == 0 ? 512 : 576, (int)blockIdx.x - 156, (int)gridDim.x - 156); }
        GSYNC();
        { const Params p = LP(); hgrn_pass<false>(p, l, shm); }
        { const Params p = LP(); phase_sample(p, l, shm); }
        if (blockIdx.x >= 48 && blockIdx.x < 80) { const Params p = LP(); phase_conv(p, l, MP, MT, (int)blockIdx.x - 48, 32); }
        { const Params p = LP(); if (blockIdx.x < 16) phase_pool(p, l, shm, 512, 528, (int)blockIdx.x, 16, false); }
        GSYNC();
        if (blockIdx.x < 8) { const Params p = LP(); float* xs = p.out + O_Y + (size_t)MP * DM; pg8::Gemm g; g.A = (const bf16_t*)(p.ws + WS_XB) + (size_t)MP * DM; g.Bt = (const bf16_t*)(p.ws + WS_WOUT) + (size_t)l * DM * DM; g.M = MS; g.N = DM; g.K = DM;
          pg8::StaticOrder S; S.init(MS, DM, (int)gridDim.x, (int)blockIdx.x); EpiRes E; E.X = xs; E.src = l == 0 ? p.x_sample : xs; E.ssq = (float*)(p.ws + WS_SSQ) + (size_t)(l + 1) * MT + MP; E.xbn = l == 0 ? (bf16_t*)(p.ws + WS_XSN) : nullptr;
          pg8::gemm_phase<EpiRes, pg8::StaticOrder, false>((PG8_LAS unsigned char*)shm, g, S, E, nullptr); }
        { const Params p = LP(); phase_pool(p, l, shm, 0, 0, (int)blockIdx.x, (int)gridDim.x, true, true); }
        { unsigned nxt = 0u;
          if (threadIdx.x == 0) { const Params p = LP(); nxt = __hip_atomic_fetch_add((unsigned*)(p.ws + WS_BAR) + 3584 + 64 * l, 1u, __ATOMIC_RELAXED, __HIP_MEMORY_SCOPE_AGENT); }
          for (;;) {
              if (threadIdx.x == 0) xst[2] = nxt;
              __syncthreads();
              const int item = (int)xst[2];
              __syncthreads();
              if (item >= 1280) break;
              if (threadIdx.x == 0) { const Params p = LP(); nxt = __hip_atomic_fetch_add((unsigned*)(p.ws + WS_BAR) + 3584 + 64 * l, 1u, __ATOMIC_RELAXED, __HIP_MEMORY_SCOPE_AGENT); }
              if (item < 256) { const Params p = LP(); phase_scan(p, l, item * NT, item * NT + NT, NT); }
              else if (item < 768) { const Params p = LP(); phase_pool(p, l, shm, item - 256, item - 255, 0, 1, false, false); }
              else { const Params p = LP(); phase_conv_prompt(p, l, (item - 768) * 1024, (item - 768) * 1024 + 1024, NT); }
          } }
        GSYNC();
        { const Params p = LP(); hgrn_pass<true>(p, l, shm); }
        GSYNC();
        if (l == 0) { const Params p = LP(); const u32x4* cs = (const u32x4*)(p.ws + WS_XSN); u32x4* cd = (u32x4*)(p.ws + WS_U + (size_t)MP * DM * 2);
          for (int i = blockIdx.x * NT + ltid(); i < 65536; i += gridDim.x * NT) cd[i] = cs[i]; }
        { const Params p = LP(); float* xs = p.out + O_Y; pg8::Gemm g; g.A = (const bf16_t*)(p.ws + WS_XB); g.Bt = (const bf16_t*)(p.ws + WS_WOUT) + (size_t)l * DM * DM; g.M = MP; g.N = DM; g.K = DM;
          pg8::StaticOrder S; S.init(MP, DM, (int)gridDim.x, (int)blockIdx.x); EpiRes E; E.X = xs; E.src = l == 0 ? p.x_prompt : xs; E.ssq = (float*)(p.ws + WS_SSQ) + (size_t)(l + 1) * MT; E.xbn = l == 0 ? (bf16_t*)(p.ws + WS_U) : nullptr;
          pg8::gemm_phase<EpiRes, pg8::StaticOrder, false>((PG8_LAS unsigned char*)shm, g, S, E, nullptr); }
        GSYNC();
        if (l == 1) { const Params p = LP(); phase_final(p); }
    }
}

extern "C" void kernel_launch(void* const* d_in, const int* in_sizes, int n_in, void* d_out, int out_size, void* d_ws, size_t ws_size, hipStream_t stream) {
    static int grid = 0;
    if (grid == 0) {
        if (n_in != 14 || out_size != (int)O_END || ws_size < WS_END) { fprintf(stderr, "kernel_launch: unexpected shapes: n_in %d out %d ws %zu\n", n_in, out_size, ws_size); grid = -1; return; }
        int dev = 0, cus = 0, per_cu = 0;
        (void)hipGetDevice(&dev); (void)hipDeviceGetAttribute(&cus, hipDeviceAttributeMultiprocessorCount, dev);
        if (hipFuncSetAttribute((const void*)hymba_fwd, hipFuncAttributeMaxDynamicSharedMemorySize, LDS_BYTES) != hipSuccess) { fprintf(stderr, "kernel_launch: hipFuncSetAttribute failed\n"); grid = -1; return; }
        if (hipOccupancyMaxActiveBlocksPerMultiprocessor(&per_cu, (const void*)hymba_fwd, NT, LDS_BYTES) != hipSuccess || per_cu < 1) { fprintf(stderr, "kernel_launch: occupancy query failed (%d)\n", per_cu); (void)hipGetLastError(); per_cu = 1; }
        if (cus < GRID) { fprintf(stderr, "kernel_launch: built for a %d-CU device, found %d CUs\n", GRID, cus); grid = -1; return; }
        grid = GRID;
    }
    if (grid < 0) return;
    Params p{};
    p.x_prompt = (const float*)d_in[0]; p.x_sample = (const float*)d_in[1]; p.state_conv = (const float*)d_in[2]; p.state_hgrn = (const float*)d_in[3]; p.state_pool = (const float*)d_in[4];
    p.norm_g = (const float*)d_in[5]; p.w_in = (const float*)d_in[6]; p.conv_w = (const float*)d_in[7]; p.hgrn_lb = (const float*)d_in[8]; p.hgrn_norm_g = (const float*)d_in[9];
    p.pool_w = (const float*)d_in[10]; p.pool_scale = (const float*)d_in[11]; p.w_out = (const float*)d_in[12]; p.final_norm_g = (const float*)d_in[13];
    p.out = (float*)d_out; p.ws = (unsigned char*)d_ws;
    if (hipMemsetAsync((char*)d_ws + WS_BAR, 0, 16384, stream) != hipSuccess) { fprintf(stderr, "kernel_launch: memset of barrier words failed\n"); return; }
    void* args[] = {&p};
    const hipError_t e = hipLaunchCooperativeKernel((const void*)hymba_fwd, dim3(grid), dim3(NT), args, LDS_BYTES, stream);
    if (e != hipSuccess) fprintf(stderr, "kernel_launch: cooperative launch failed: %s (grid %d)\n", hipGetErrorString(e), grid);
}
```

```cpp
#include <hip/hip_runtime.h>
#include <hip/hip_cooperative_groups.h>
#include <cstdio>
namespace cg = cooperative_groups;
namespace pg8 {
#define PG8_LAS __attribute__((address_space(3)))
typedef unsigned short bf16_t;
typedef short bf16x8 __attribute__((ext_vector_type(8)));
typedef float f32x4 __attribute__((ext_vector_type(4)));
typedef unsigned u32x4 __attribute__((ext_vector_type(4)));
constexpr int BM = 256, BK = 64, HALF = 128, HTB = HALF * BK * 2  , STAGE_BYTES = 8 * HTB, NXCD = 8, WGM = 8;

__host__ __device__ __forceinline__ int lds_byte(int r, int c) { const int st = (r >> 4) * 2 + (c >> 5), rr = r & 15, cc = c & 31, ob = rr * 64 + cc * 2; return st * 1024 + (ob ^ (((ob >> 9) & 1) << 5)); }
__host__ __device__ __forceinline__ void stage_rc(int b, int& R, int& C) { const int st = b / 1024, sb = b % 1024, swz = sb ^ (((sb >> 9) & 1) << 5); R = (st >> 1) * 16 + swz / 64; C = (st & 1) * 32 + (swz % 64) / 2; }
__host__ __device__ __forceinline__ int perm32(int rho) { const int n = rho >> 4, i = rho & 15; return 8 * (i >> 2) + 4 * n + (i & 3); }

struct Unit { int pm, pn; };
struct Gemm { const bf16_t* A; const bf16_t* Bt; int M, N, K; };

struct StaticOrder {
    int nM, nN, nwg, G, c;
    __host__ __device__ void init(int M, int N, int G_, int c_) { nM = M / BM; nN = N / BM; nwg = nM * nN; G = G_; c = c_; }
    __host__ __device__ bool next(int i, Unit& u) const {
        const long L = (long)i * G + c; if (L >= nwg) return false;
        int wgid = (int)L; { const int q = nwg / NXCD, r = nwg % NXCD, xcd = wgid % NXCD, off = wgid / NXCD; wgid = (xcd < r ? xcd * (q + 1) : r * (q + 1) + (xcd - r) * q) + off; }
        const int nig = WGM * nN, gid = wgid / nig, fm = gid * WGM, gsz = (nM - fm) < WGM ? (nM - fm) : WGM;
        u.pm = fm + ((wgid % nig) % gsz); u.pn = (wgid % nig) / gsz; return true;
    }
    __device__ __forceinline__ void a_ready(const Unit&) const {}
    __device__ __forceinline__ void done(const Unit&) const {}
};
__device__ __forceinline__ unsigned cvt_pk_bf16(float lo, float hi) { unsigned r; asm volatile("v_cvt_pk_bf16_f32 %0, %1, %2" : "=v"(r) : "v"(lo), "v"(hi)); return r; }
template <class Epi, class Sched, bool STAMP = false>
__device__ __forceinline__ void gemm_phase(PG8_LAS unsigned char* lds, const Gemm g, const Sched& S, const Epi& E, unsigned long long* stamps) {
    int tid_l = threadIdx.x; asm volatile("" : "+v"(tid_l));
    const int tid = tid_l, wid = __builtin_amdgcn_readfirstlane(tid >> 6), lane = tid & 63, wr = wid >> 2, wc = wid & 3, fr = lane & 15, fq = lane >> 4;
    const int K = g.K, nt = K / BK;
    int ts_lo = 0, ts_hi = 0, nts = 0; const unsigned long long rt_entry = STAMP ? (unsigned long long)wall_clock64() : 0ull;
#define PG8_STAMP() do { if (STAMP && wid == 0 && nts < 64) { const unsigned long long _c = (unsigned long long)clock64(); \
        ts_lo = (lane == nts) ? (int)(unsigned)_c : ts_lo; ts_hi = (lane == nts) ? (int)(unsigned)(_c >> 32) : ts_hi; ++nts; } } while (0)
    PG8_STAMP();
    unsigned voffA[2], voffB[2];
#pragma unroll
    for (int i = 0; i < 2; ++i) { int R, C; stage_rc(tid * 16 + i * 8192, R, C); const int Rb = Epi::PERM ? ((R & ~31) + perm32(R & 31)) : R;
        voffA[i] = (unsigned)(R * K + C) * 2u; voffB[i] = (unsigned)(Rb * K + C) * 2u; }
    const size_t kstep = (size_t)(BK * 2);
    const size_t hstep = (size_t)HALF * K * 2;
    const size_t tstep = 2 * hstep;
    const unsigned ldsw = (unsigned)wid * 1024u;
    const int aoff = lds_byte(wr * 64 + fr, fq * 8), boff = lds_byte(wc * 32 + fr, fq * 8);
#define PG8_SA(b, h) (((b) * 2 + (h)) * HTB)
#define PG8_SB(b, h) ((4 + (b) * 2 + (h)) * HTB)
#define PG8_STAGE(bufoff, gbase, voff) do { _Pragma("unroll") for (int _i = 0; _i < 2; ++_i) \
        __builtin_amdgcn_global_load_lds((const unsigned*)((const char*)(gbase) + (voff)[_i]), (PG8_LAS unsigned*)(lds + (bufoff) + ldsw + _i * 8192), 16, 0, 0); } while (0)
#define PG8_LDA(dst, b, h) do { _Pragma("unroll") for (int m = 0; m < 4; ++m) _Pragma("unroll") for (int k = 0; k < 2; ++k) dst[m][k] = *(const PG8_LAS bf16x8*)(lds + PG8_SA(b, h) + aoff + m * 2048 + k * 1024); } while (0)
#define PG8_LDB(dst, b, h) do { _Pragma("unroll") for (int n = 0; n < 2; ++n) _Pragma("unroll") for (int k = 0; k < 2; ++k) dst[n][k] = *(const PG8_LAS bf16x8*)(lds + PG8_SB(b, h) + boff + n * 2048 + k * 1024); } while (0)
#define PG8_MMA(ai, bj, At, Bt) do { __builtin_amdgcn_s_setprio(1); _Pragma("unroll") for (int m = 0; m < 4; ++m) _Pragma("unroll") for (int n = 0; n < 2; ++n) _Pragma("unroll") for (int k = 0; k < 2; ++k) \
        acc[ai][bj][m][n] = __builtin_amdgcn_mfma_f32_16x16x32_bf16(Bt[n][k], At[m][k], acc[ai][bj][m][n], 0, 0, 0); __builtin_amdgcn_s_setprio(0); } while (0)
#define PG8_WAIT_V(n) asm volatile("s_waitcnt vmcnt(" #n ")" ::: "memory")
#define PG8_WAIT_L(n) asm volatile("s_waitcnt lgkmcnt(" #n ")" ::: "memory")
#define PG8_BAR __builtin_amdgcn_s_barrier()
#define PG8_SCHED __builtin_amdgcn_sched_barrier(0)
    Unit cur, nxt; int ui = 0;
    if (!S.next(0, cur)) return;
    f32x4 acc[2][2][4][2];
#pragma unroll
    for (int a = 0; a < 2; ++a)
#pragma unroll
        for (int b = 0; b < 2; ++b)
#pragma unroll
            for (int m = 0; m < 4; ++m)
#pragma unroll
                for (int n = 0; n < 2; ++n) acc[a][b][m][n] = (f32x4){0.f, 0.f, 0.f, 0.f};
    bf16x8 At[4][2], B0[2][2], B1[2][2];
    const char* cA = (const char*)g.A + (size_t)cur.pm * tstep; const char* cB = (const char*)g.Bt + (size_t)cur.pn * tstep;
    S.a_ready(cur);
    PG8_STAGE(PG8_SB(0, 0), cB, voffB); PG8_STAGE(PG8_SA(0, 0), cA, voffA); PG8_STAGE(PG8_SB(0, 1), cB + hstep, voffB); PG8_STAGE(PG8_SA(0, 1), cA + hstep, voffA);
    if (wr == 1) PG8_BAR;
    PG8_WAIT_V(4); PG8_BAR;
    PG8_STAGE(PG8_SB(1, 0), cB + kstep, voffB); PG8_STAGE(PG8_SA(1, 0), cA + kstep, voffA); PG8_STAGE(PG8_SB(1, 1), cB + hstep + kstep, voffB);
    PG8_WAIT_V(6); PG8_BAR;
    PG8_STAMP();
    for (;;) {
        const bool has_next = S.next(ui + 1, nxt);
        const char* nA = has_next ? (const char*)g.A + (size_t)nxt.pm * tstep : cA; const char* nB = has_next ? (const char*)g.Bt + (size_t)nxt.pn * tstep : cB;
        for (int t = 0; t < nt; t += 2) {
            const bool last = (t == nt - 2);
            const char* a1 = cA + (size_t)(t + 1) * kstep;
            const char* a2 = last ? nA : cA + (size_t)(t + 2) * kstep; const char* b2 = last ? nB : cB + (size_t)(t + 2) * kstep;
            const char* a3 = a2 + kstep; const char* b3 = b2 + kstep;
            if (last && has_next) S.a_ready(nxt);
            if (last) E.prefetch(cur, wr, fr, lds, wid);
            PG8_LDB(B0, 0, 0); PG8_SCHED; PG8_LDA(At, 0, 0); PG8_STAGE(PG8_SA(1, 1), a1 + hstep, voffA);
            PG8_WAIT_L(8); PG8_BAR; PG8_WAIT_L(0); PG8_MMA(0, 0, At, B0); PG8_BAR; PG8_SCHED;
            PG8_LDB(B1, 0, 1); PG8_STAGE(PG8_SB(0, 0), b2, voffB);
            PG8_BAR; PG8_WAIT_L(0); PG8_MMA(0, 1, At, B1); PG8_BAR;
            PG8_LDA(At, 0, 1); PG8_STAGE(PG8_SA(0, 0), a2, voffA);
            PG8_BAR; PG8_WAIT_L(0); PG8_MMA(1, 0, At, B0); PG8_BAR; PG8_SCHED;
            PG8_STAGE(PG8_SB(0, 1), b2 + hstep, voffB);
            PG8_WAIT_V(6); PG8_BAR; PG8_MMA(1, 1, At, B1); PG8_BAR;
            PG8_LDB(B0, 1, 0); PG8_SCHED; PG8_LDA(At, 1, 0); PG8_STAGE(PG8_SA(0, 1), a2 + hstep, voffA);
            PG8_WAIT_L(8); PG8_BAR; PG8_WAIT_L(0); PG8_MMA(0, 0, At, B0); PG8_BAR; PG8_SCHED;
            PG8_LDB(B1, 1, 1); PG8_STAGE(PG8_SB(1, 0), b3, voffB);
            PG8_BAR; PG8_WAIT_L(0); PG8_MMA(0, 1, At, B1); PG8_BAR;
            PG8_LDA(At, 1, 1); PG8_STAGE(PG8_SA(1, 0), a3, voffA);
            PG8_BAR; PG8_WAIT_L(0); PG8_MMA(1, 0, At, B0); PG8_BAR; PG8_SCHED;
            PG8_STAGE(PG8_SB(1, 1), b3 + hstep, voffB);
            PG8_WAIT_V(6); PG8_BAR; PG8_MMA(1, 1, At, B1); PG8_BAR;
        }
        PG8_STAMP();
        if constexpr (!Epi::AFTER_DRAIN) { E(acc, cur, wr, wc, fr, fq, lds, wid, lane); S.done(cur); }
        PG8_STAMP();
        if (!has_next) break;
#pragma unroll
        for (int a = 0; a < 2; ++a)
#pragma unroll
            for (int b = 0; b < 2; ++b)
#pragma unroll
                for (int m = 0; m < 4; ++m)
#pragma unroll
                    for (int n = 0; n < 2; ++n) acc[a][b][m][n] = (f32x4){0.f, 0.f, 0.f, 0.f};
        cur = nxt; cA = nA; cB = nB; ++ui;
    }
    PG8_WAIT_V(0);
    if (wr == 0) PG8_BAR;
    PG8_BAR;
    if constexpr (Epi::AFTER_DRAIN) { E.fused(acc, cur, wr, wc, fr, fq, lds, wid, lane); S.done(cur); }
    PG8_STAMP();
    if (STAMP && wid == 0) { stamps[lane] = lane < nts ? (((unsigned long long)(unsigned)ts_hi << 32) | (unsigned)ts_lo) : 0ull;
        if (lane == 62) stamps[62] = rt_entry; if (lane == 63) stamps[63] = (unsigned long long)wall_clock64(); }
#undef PG8_STAMP
#undef PG8_SA
#undef PG8_SB
#undef PG8_STAGE
#undef PG8_LDA
#undef PG8_LDB
#undef PG8_MMA
#undef PG8_WAIT_V
#undef PG8_WAIT_L
#undef PG8_BAR
#undef PG8_SCHED
}
}
#define XB_TMO      128
#define XB_XCNT(j)  (256  + 64 * (j))
#define XB_XSUB(j)  (1280 + 64 * (j))
#define XB_XGEN(j)  (2304 + 64 * (j))
#define XB_TOP      3328
#define XB_TOPGEN   3392
#define XCD_BAR_WORDS 3456
#define XB_SPIN_CAP (1u << 18)
#define LAS __attribute__((address_space(3)))

__device__ __forceinline__ unsigned xb_ld(unsigned* p)              { return __hip_atomic_load(p, __ATOMIC_RELAXED, __HIP_MEMORY_SCOPE_AGENT); }
__device__ __forceinline__ unsigned xb_add(unsigned* p, unsigned v) { return __hip_atomic_fetch_add(p, v, __ATOMIC_RELAXED, __HIP_MEMORY_SCOPE_AGENT); }
__device__ __forceinline__ unsigned xb_xcc_id() { return (unsigned)__builtin_amdgcn_s_getreg((3 << 11) | 20) & 0xFu; }
#define XB_SPIN(cond, bar) do { unsigned _sp = 0; while (cond) { __builtin_amdgcn_s_sleep(1); \
    if ((++_sp & 255u) == 0u) { if (xb_ld(&(bar)[XB_TMO])) break; if (_sp > XB_SPIN_CAP) { atomicAdd(&(bar)[XB_TMO], 1u); break; } } } } while (0)

struct XcdBarrier {
    unsigned* bar; unsigned x;
    volatile LAS unsigned* st;
};

__device__ __forceinline__ XcdBarrier xcd_barrier_post(unsigned* bar, volatile LAS unsigned* st) {
    XcdBarrier b; b.bar = bar; b.x = xb_xcc_id(); b.st = st;
    if (threadIdx.x == 0) (void)xb_add(&bar[XB_XCNT(b.x)], 1u);
    return b;
}
__device__ __forceinline__ void xcd_barrier_complete(unsigned* bar, unsigned x, unsigned& nloc, unsigned& nx) {
    const unsigned G = gridDim.x * gridDim.y * gridDim.z;
    unsigned sum, cnt, mine, sp = 0u;
    for (;;) {
        sum = 0u; cnt = 0u; mine = 0u;
#pragma unroll
        for (unsigned j = 0; j < 16; ++j) { const unsigned c = xb_ld(&bar[XB_XCNT(j)]); sum += c; cnt += (c > 0u) ? 1u : 0u; mine = (j == x) ? c : mine; }
        if (sum == G) break;
        __builtin_amdgcn_s_sleep(1);
        if ((++sp & 255u) == 0u) { if (xb_ld(&bar[XB_TMO])) break; if (sp > XB_SPIN_CAP) { atomicAdd(&bar[XB_TMO], 1u); break; } }
    }
    nloc = mine > 0u ? mine : 1u; nx = cnt > 0u ? cnt : 1u;
}

__device__ __forceinline__ void xcd_barrier(const XcdBarrier& b) {
    asm volatile("s_waitcnt vmcnt(0)" ::: "memory");
    __syncthreads();
    if (threadIdx.x == 0) {
        unsigned* bar = b.bar;
        __builtin_amdgcn_s_waitcnt(0);
        unsigned nloc = b.st[0], nx = b.st[1];
        if (nloc == 0u) { xcd_barrier_complete(bar, b.x, nloc, nx); b.st[0] = nloc; b.st[1] = nx; }
        const unsigned old = xb_add(&bar[XB_XSUB(b.x)], 1u);
        const unsigned gen = old / nloc;
        if (old + 1u == (gen + 1u) * nloc) {
            __builtin_amdgcn_fence(__ATOMIC_RELEASE, "agent");
            asm volatile("s_waitcnt vmcnt(0)" ::: "memory");
            const unsigned og = xb_add(&bar[XB_TOP], 1u);
            const unsigned tg = og / nx;
            if (og + 1u == (tg + 1u) * nx) xb_add(&bar[XB_TOPGEN], 1u);
            else XB_SPIN(xb_ld(&bar[XB_TOPGEN]) == tg, bar);
            __builtin_amdgcn_fence(__ATOMIC_ACQUIRE, "agent");
            xb_add(&bar[XB_XGEN(b.x)], 1u);
            asm volatile("s_waitcnt vmcnt(0)" ::: "memory");
        } else {
            XB_SPIN(xb_ld(&bar[XB_XGEN(b.x)]) == gen, bar);
            __builtin_amdgcn_fence(__ATOMIC_ACQUIRE, "agent");
            asm volatile("s_waitcnt vmcnt(0)" ::: "memory");
        }
    }
    __syncthreads();
}


#define DI __device__ __forceinline__
typedef pg8::bf16_t bf16_t;
typedef short bf16x8 __attribute__((ext_vector_type(8)));
typedef float f32x4 __attribute__((ext_vector_type(4)));
typedef unsigned u32x4 __attribute__((ext_vector_type(4)));
typedef unsigned u32x2 __attribute__((ext_vector_type(2)));

constexpr int MP = 16384, MS = 512, MT = MP + MS, DM = 1024, DIN = 3584, NT = 512;
constexpr int C_AH = 0, C_AB = 256, C_AC = 512, C_AG = 768, C_Q = 1024, C_F = 1536, C_I = 2048, C_GB = 2560, C_PV = 3072, C_PG = 3328;
constexpr float EPS = 1e-6f;
constexpr size_t O_Y = 0, O_NCP = 17301504, O_NHP = 17309696, O_NPP = 18358272, O_NCS = 18419712, O_NHS = 18550784, O_NPS = 35328000, O_END = 36311040;
constexpr size_t WS_WIN = 0, WS_WOUT = 14680064, WS_RSTD = 18874368, WS_DEC = 18941952, WS_XB = 19466240, WS_Z = 54069248, WS_U = 175179776, WS_BAR = 242288640, WS_SSQ = 242288640 + 16384, WS_XSN = 242288640 + 16384 + 3 * 67584, WS_EBR = 242288640 + 16384 + 3 * 67584 + 1048576, WS_END = 242288640 + 16384 + 3 * 67584 + 1048576 + 524288;
#ifndef PASSC_PREFETCH
#define PASSC_PREFETCH 1
#endif
constexpr int GRID = 256;
constexpr int EPF_OFF = 131072 + 64;
constexpr int LDS_BYTES = 131072 + 64 + 16384;
constexpr int L_QM = 0, L_KM = 17408, L_VT = 34816, L_ST = 53248, L_AM = 88064, L_TOT = 97280, L_EB = 101376, L_SSQ = 101888;

struct Params {
    const float *x_prompt, *x_sample, *state_conv, *state_hgrn, *state_pool, *norm_g, *w_in, *conv_w, *hgrn_lb, *hgrn_norm_g, *pool_w, *pool_scale, *w_out, *final_norm_g;
    float* out; unsigned char* ws;
};

DI float bf2f(bf16_t b) { return __uint_as_float(((unsigned)b) << 16); }
typedef __bf16 hbf2 __attribute__((ext_vector_type(2)));
typedef float hf2 __attribute__((ext_vector_type(2)));
DI unsigned pk2(float lo, float hi) { const hf2 v = {lo, hi}; return __builtin_bit_cast(unsigned, __builtin_convertvector(v, hbf2)); }
DI bf16_t f2bf(float f) { return (bf16_t)(pk2(f, f) & 0xffffu); }
DI float frcp(float x) { return __builtin_amdgcn_rcpf(x); }
DI void unpack8(u32x4 w, float (&o)[8]) {
    o[0] = __uint_as_float(w.x << 16); o[1] = __uint_as_float(w.x & 0xffff0000u); o[2] = __uint_as_float(w.y << 16); o[3] = __uint_as_float(w.y & 0xffff0000u);
    o[4] = __uint_as_float(w.z << 16); o[5] = __uint_as_float(w.z & 0xffff0000u); o[6] = __uint_as_float(w.w << 16); o[7] = __uint_as_float(w.w & 0xffff0000u);
}
DI int ltid() { int t = threadIdx.x; asm volatile("" : "+v"(t)); return t; }
DI float4 ldnt4(const float* p) { const f32x4 v = __builtin_nontemporal_load((const f32x4*)p); return make_float4(v[0], v[1], v[2], v[3]); }
DI void stnt4(float* p, float4 v) { const f32x4 w = {v.x, v.y, v.z, v.w}; __builtin_nontemporal_store(w, (f32x4*)p); }
DI float silu(float x) { return x * frcp(1.0f + __expf(-x)); }
DI float wave_sum(float v) {
#pragma unroll
    for (int o = 32; o >= 1; o >>= 1) v += __shfl_xor(v, o, 64);
    return v;
}

struct EpiZ {
    static constexpr bool PERM = true, AFTER_DRAIN = false;
    bf16_t* O; const float* ssq;
    DI void prefetch(const pg8::Unit& u, int wr, int fr, PG8_LAS unsigned char* lds, int wid) const {
        if (ssq) { const float* g = ssq + u.pm * 256 + wr * 64 + fr;
#pragma unroll
            for (int i = 0; i < 8; ++i) __builtin_amdgcn_global_load_lds((const unsigned*)(g + (i >> 2) * 128 + (i & 3) * 16), (PG8_LAS unsigned*)(lds + EPF_OFF + wid * 2048 + i * 256), 4, 0, 0); }
    }
    DI void operator()(const f32x4 (&acc)[2][2][4][2], const pg8::Unit& u, int wr, int wc, int fr, int fq, PG8_LAS unsigned char* lds, int wid, int lane) const {
        const int row0 = u.pm * 256 + wr * 64 + fr, col0 = u.pn * 256 + wc * 32 + 8 * fq;
#pragma unroll
        for (int ai = 0; ai < 2; ++ai)
#pragma unroll
            for (int m = 0; m < 4; ++m) {
                const int r = row0 + ai * 128 + m * 16; const float s = ssq ? rsqrtf(*(const PG8_LAS float*)(lds + EPF_OFF + wid * 2048 + (ai * 4 + m) * 256 + lane * 4) * (1.0f / DM) + EPS) : 1.0f; bf16_t* rowp = O + (size_t)r * DIN + col0;
#pragma unroll
                for (int bj = 0; bj < 2; ++bj) { const f32x4 v0 = acc[ai][bj][m][0] * s, v1 = acc[ai][bj][m][1] * s;
                    u32x4 w; w.x = pg8::cvt_pk_bf16(v0[0], v0[1]); w.y = pg8::cvt_pk_bf16(v0[2], v0[3]); w.z = pg8::cvt_pk_bf16(v1[0], v1[1]); w.w = pg8::cvt_pk_bf16(v1[2], v1[3]);
                    *(u32x4*)(rowp + bj * 128) = w; } }
    }
};
struct EpiRes {
    static constexpr bool PERM = false, AFTER_DRAIN = true;
    float* X; const float* src; float* ssq; bf16_t* xbn;
    DI void prefetch(const pg8::Unit&, int, int, PG8_LAS unsigned char*, int) const {}
    DI void operator()(const f32x4 (&)[2][2][4][2], const pg8::Unit&, int, int, int, int, PG8_LAS unsigned char*, int, int) const {}
    DI void fused(const f32x4 (&acc)[2][2][4][2], const pg8::Unit& u, int wr, int wc, int fr, int fq, PG8_LAS unsigned char* lds, int wid, int lane) const {
        typedef PG8_LAS f32x4* LP4;
#pragma unroll
        for (int ai = 0; ai < 2; ++ai) {
#pragma unroll
            for (int m = 0; m < 4; ++m) { const int rl = wr * 64 + m * 16 + fr;
#pragma unroll
                for (int bj = 0; bj < 2; ++bj)
#pragma unroll
                    for (int n = 0; n < 2; ++n) { const int c4 = bj * 32 + wc * 8 + n * 4 + fq; *(LP4)(lds + rl * 1024 + ((c4 ^ (rl & 15)) << 4)) = acc[ai][bj][m][n]; } }
            __syncthreads();
#pragma unroll
            for (int half = 0; half < 2; ++half) {
                f32x4 sv[8];
#pragma unroll
                for (int rr = 0; rr < 8; ++rr) { const int row = wid * 16 + half * 8 + rr; const size_t go = (size_t)(u.pm * 256 + ai * 128 + row) * DM + u.pn * 256 + lane * 4; sv[rr] = __builtin_nontemporal_load((const f32x4*)(src + go)); }
                float part[8];
#pragma unroll
                for (int rr = 0; rr < 8; ++rr) { const int row = wid * 16 + half * 8 + rr; const int gr = u.pm * 256 + ai * 128 + row; const size_t go = (size_t)gr * DM + u.pn * 256 + lane * 4;
                    const f32x4 o = sv[rr] + *(LP4)(lds + row * 1024 + ((lane ^ (row & 15)) << 4));
                    *(f32x4*)(X + go) = o;
                    if (xbn) { u32x2 w; w.x = pk2(o[0], o[1]); w.y = pk2(o[2], o[3]); *(u32x2*)(xbn + go) = w; }
                    part[rr] = o[0] * o[0] + o[1] * o[1] + o[2] * o[2] + o[3] * o[3]; }
                { const bool h1 = (lane & 32) != 0, h2 = (lane & 16) != 0, h3 = (lane & 8) != 0; float q4[4], q2[2];
#pragma unroll
                  for (int i = 0; i < 4; ++i) { const float snd = h1 ? part[i] : part[i + 4], kp = h1 ? part[i + 4] : part[i]; q4[i] = kp + __shfl_xor(snd, 32, 64); }
#pragma unroll
                  for (int i = 0; i < 2; ++i) { const float snd = h2 ? q4[i] : q4[i + 2], kp = h2 ? q4[i + 2] : q4[i]; q2[i] = kp + __shfl_xor(snd, 16, 64); }
                  float q1; { const float snd = h3 ? q2[0] : q2[1], kp = h3 ? q2[1] : q2[0]; q1 = kp + __shfl_xor(snd, 8, 64); }
                  q1 += __shfl_xor(q1, 4, 64); q1 += __shfl_xor(q1, 2, 64); q1 += __shfl_xor(q1, 1, 64);
                  const int rsel = (h3 ? 1 : 0) + (h2 ? 2 : 0) + (h1 ? 4 : 0);
                  if ((lane & 7) == 0) (void)__hip_atomic_fetch_add(ssq + u.pm * 256 + ai * 128 + wid * 16 + half * 8 + rsel, q1, __ATOMIC_RELAXED, __HIP_MEMORY_SCOPE_AGENT); }
            }
            __syncthreads();
        }
    }
};

struct WTile { const float* src; bf16_t* dst; const float* g; int N, kt, nt; };
DI WTile wtile_of(const Params& p, int ti) {
    constexpr int T_IN = 2 * 16 * 56; WTile w;
    bf16_t* win = (bf16_t*)(p.ws + WS_WIN); bf16_t* wout = (bf16_t*)(p.ws + WS_WOUT);
    if (ti < T_IN) { const int l = ti / (16 * 56), r = ti % (16 * 56); w.kt = r / 56; w.nt = r % 56; w.N = DIN; w.src = p.w_in + (size_t)l * DM * DIN; w.dst = win + (size_t)l * DIN * DM; w.g = p.norm_g + l * DM; }
    else { const int tt = ti - T_IN; const int l = tt / 256, r = tt % 256; w.kt = r / 16; w.nt = r % 16; w.N = DM; w.src = p.w_out + (size_t)l * DM * DM; w.dst = wout + (size_t)l * DM * DM; w.g = nullptr; }
    return w;
}
DI void wtile_ld(const WTile& w, int tid, float4 (&v)[2], float (&gg)[2]) {
#pragma unroll
    for (int i = 0; i < 2; ++i) { const int k = (tid >> 4) + 32 * i, n4 = (tid & 15) * 4;
        v[i] = ldnt4(w.src + (size_t)(w.kt * 64 + k) * w.N + w.nt * 64 + n4); gg[i] = w.g ? w.g[w.kt * 64 + k] : 1.0f; }
}
DI void phase_weights(const Params& p, unsigned char* lds, int ti_lo, int T_ALL, int blk, int nblk) {
    const int tid = ltid(); float* t = (float*)lds;
    float4 v[2]; float gg[2];
    int ti = ti_lo + blk;
    if (ti < T_ALL) { const WTile w = wtile_of(p, ti); wtile_ld(w, tid, v, gg); }
    for (; ti < T_ALL; ti += nblk) {
        const WTile w = wtile_of(p, ti);
#pragma unroll
        for (int i = 0; i < 2; ++i) { const int k = (tid >> 4) + 32 * i, n4 = (tid & 15) * 4;
            t[k * 65 + n4 + 0] = v[i].x * gg[i]; t[k * 65 + n4 + 1] = v[i].y * gg[i]; t[k * 65 + n4 + 2] = v[i].z * gg[i]; t[k * 65 + n4 + 3] = v[i].w * gg[i]; }
        if (ti + nblk < T_ALL) { const WTile wn = wtile_of(p, ti + nblk); wtile_ld(wn, tid, v, gg); }
        __syncthreads();
        { const int n = tid >> 3, k8 = (tid & 7) * 8; u32x4 o;
          o.x = pk2(t[(k8 + 0) * 65 + n], t[(k8 + 1) * 65 + n]); o.y = pk2(t[(k8 + 2) * 65 + n], t[(k8 + 3) * 65 + n]);
          o.z = pk2(t[(k8 + 4) * 65 + n], t[(k8 + 5) * 65 + n]); o.w = pk2(t[(k8 + 6) * 65 + n], t[(k8 + 7) * 65 + n]);
          *(u32x4*)(w.dst + (size_t)(w.nt * 64 + n) * DM + w.kt * 64 + k8) = o; }
        __syncthreads();
    }
}

DI void phase_norm0(const Params& p) {
    const int tid_ = ltid(), wid = tid_ >> 6, lane = tid_ & 63;
    bf16_t* xb = (bf16_t*)(p.ws + WS_XB); float* ssq = (float*)(p.ws + WS_SSQ);
    for (int i = blockIdx.x * NT + tid_; i < 2 * MT; i += gridDim.x * NT) ssq[MT + i] = 0.f;
    const int rstride = gridDim.x * 8;
    for (int row = blockIdx.x * 8 + wid; row < MT; row += 2 * rstride) {
        const int row2 = row + rstride; const bool two = row2 < MT; const int rb = two ? row2 : row;
        const float* sa = row < MP ? p.x_prompt + (size_t)row * DM : p.x_sample + (size_t)(row - MP) * DM;
        const float* sb = rb < MP ? p.x_prompt + (size_t)rb * DM : p.x_sample + (size_t)(rb - MP) * DM;
        float4 va[4], vb[4]; float ssa = 0.f, ssb = 0.f;
#pragma unroll
        for (int i = 0; i < 4; ++i) { va[i] = ldnt4(sa + i * 256 + lane * 4); vb[i] = ldnt4(sb + i * 256 + lane * 4); }
#pragma unroll
        for (int i = 0; i < 4; ++i) { ssa += va[i].x * va[i].x + va[i].y * va[i].y + va[i].z * va[i].z + va[i].w * va[i].w; ssb += vb[i].x * vb[i].x + vb[i].y * vb[i].y + vb[i].z * vb[i].z + vb[i].w * vb[i].w; }
        ssa = wave_sum(ssa); ssb = wave_sum(ssb);
        const float ra = rsqrtf(ssa * (1.0f / DM) + EPS), rb2 = rsqrtf(ssb * (1.0f / DM) + EPS);
#pragma unroll
        for (int i = 0; i < 4; ++i) { u32x2 w; w.x = pk2(va[i].x * ra, va[i].y * ra); w.y = pk2(va[i].z * ra, va[i].w * ra); *(u32x2*)(xb + (size_t)row * DM + i * 256 + lane * 4) = w;
            if (two) { u32x2 w2; w2.x = pk2(vb[i].x * rb2, vb[i].y * rb2); w2.y = pk2(vb[i].z * rb2, vb[i].w * rb2); *(u32x2*)(xb + (size_t)row2 * DM + i * 256 + lane * 4) = w2; } }
    }
}
DI void phase_final(const Params& p) {
    float* xs = p.out + O_Y; const float* ssq = (const float*)(p.ws + WS_SSQ) + 2 * MT;
    const int stride = gridDim.x * NT;
    for (int i0 = blockIdx.x * NT + ltid(); i0 < MT * 256; i0 += 8 * stride) {
        float4 v[8]; float r[8];
#pragma unroll
        for (int k = 0; k < 8; ++k) { const int idx = i0 + k * stride; if (idx < MT * 256) { v[k] = ldnt4(xs + (size_t)idx * 4); r[k] = ssq[idx >> 8]; } }
#pragma unroll
        for (int k = 0; k < 8; ++k) { const int idx = i0 + k * stride; if (idx < MT * 256) { const float rr = rsqrtf(r[k] * (1.0f / DM) + EPS);
            const float4 g = *(const float4*)(p.final_norm_g + (idx & 255) * 4); float4 o = v[k];
            o.x *= rr * g.x; o.y *= rr * g.y; o.z *= rr * g.z; o.w *= rr * g.w; stnt4(xs + (size_t)idx * 4, o); } }
    }
}

DI void phase_conv(const Params& p, int l, int row_lo, int row_hi, int blk, int nblk) {
    const bf16_t* z = (const bf16_t*)(p.ws + WS_Z); bf16_t* mix = (bf16_t*)(p.ws + WS_XB);
    const float* cw = p.conv_w + l * 3 * 256;
    for (int idx = row_lo * 32 + blk * NT + ltid(); idx < row_hi * 32; idx += nblk * NT) {
        const int row = idx >> 5, c = (idx & 31) * 8;
        int t, T; const float* buf; float* nc;
        if (row < MP) { const int b = row >> 11; t = row & 2047; T = 2048; buf = nullptr; nc = p.out + O_NCP + (size_t)(l * 8 + b) * 512; }
        else { const int rr = row - MP; const int b = rr >> 2; t = rr & 3; T = 4; buf = p.state_conv + (size_t)(l * 128 + b) * 512; nc = p.out + O_NCS + (size_t)(l * 128 + b) * 512; }
        float u[3][8];
#pragma unroll
        for (int j = 0; j < 3; ++j) {
            const int tp = t - 2 + j;
            if (tp >= 0) { const bf16_t* zr = z + (size_t)(row - 2 + j) * DIN + c; float ah[8], ac[8]; unpack8(*(const u32x4*)(zr + C_AH), ah); unpack8(*(const u32x4*)(zr + C_AC), ac);
#pragma unroll
                for (int i = 0; i < 8; ++i) u[j][i] = ah[i] * ac[i]; }
            else if (buf) { const float4 a = *(const float4*)(buf + (tp + 2) * 256 + c), b4 = *(const float4*)(buf + (tp + 2) * 256 + c + 4);
                u[j][0] = a.x; u[j][1] = a.y; u[j][2] = a.z; u[j][3] = a.w; u[j][4] = b4.x; u[j][5] = b4.y; u[j][6] = b4.z; u[j][7] = b4.w; }
            else {
#pragma unroll
                for (int i = 0; i < 8; ++i) u[j][i] = 0.f; }
        }
        const bf16_t* zr = z + (size_t)row * DIN + c; float ab[8], ag[8]; unpack8(*(const u32x4*)(zr + C_AB), ab); unpack8(*(const u32x4*)(zr + C_AG), ag);
        float w0[8], w1[8], w2[8];
        { const float4 a0 = *(const float4*)(cw + c), a1 = *(const float4*)(cw + c + 4), b0 = *(const float4*)(cw + 256 + c), b1 = *(const float4*)(cw + 256 + c + 4), c0 = *(const float4*)(cw + 512 + c), c1 = *(const float4*)(cw + 512 + c + 4);
          w0[0] = a0.x; w0[1] = a0.y; w0[2] = a0.z; w0[3] = a0.w; w0[4] = a1.x; w0[5] = a1.y; w0[6] = a1.z; w0[7] = a1.w;
          w1[0] = b0.x; w1[1] = b0.y; w1[2] = b0.z; w1[3] = b0.w; w1[4] = b1.x; w1[5] = b1.y; w1[6] = b1.z; w1[7] = b1.w;
          w2[0] = c0.x; w2[1] = c0.y; w2[2] = c0.z; w2[3] = c0.w; w2[4] = c1.x; w2[5] = c1.y; w2[6] = c1.z; w2[7] = c1.w; }
        float o[8];
#pragma unroll
        for (int i = 0; i < 8; ++i) { const float y = w0[i] * u[0][i] + w1[i] * u[1][i] + w2[i] * u[2][i]; o[i] = ab[i] * y * silu(ag[i]); }
        u32x4 w; w.x = pk2(o[0], o[1]); w.y = pk2(o[2], o[3]); w.z = pk2(o[4], o[5]); w.w = pk2(o[6], o[7]);
        *(u32x4*)(mix + (size_t)row * DM + c) = w;
        if (t >= T - 2) { float* d = nc + (t - (T - 2)) * 256 + c; *(float4*)d = make_float4(u[2][0], u[2][1], u[2][2], u[2][3]); *(float4*)(d + 4) = make_float4(u[2][4], u[2][5], u[2][6], u[2][7]); }
    }
}

DI void conv_ld(const bf16_t* z, int idx, u32x4 (&r)[8]) {
    const int row = idx >> 5, c = (idx & 31) * 8, t = row & 2047; const bf16_t* zr = z + (size_t)row * DIN + c;
#pragma unroll
    for (int j = 0; j < 3; ++j) { const bf16_t* q = zr - (size_t)((t - 2 + j >= 0) ? (2 - j) * DIN : 0); r[2 * j] = *(const u32x4*)(q + C_AH); r[2 * j + 1] = *(const u32x4*)(q + C_AC); }
    r[6] = *(const u32x4*)(zr + C_AB); r[7] = *(const u32x4*)(zr + C_AG);
}
DI void conv_fin(const Params& p, int l, int idx, const u32x4 (&r)[8]) {
    const int row = idx >> 5, c = (idx & 31) * 8, t = row & 2047; const float* cw = p.conv_w + l * 3 * 256;
    float u[3][8];
#pragma unroll
    for (int j = 0; j < 3; ++j) { float ah[8], ac[8]; unpack8(r[2 * j], ah); unpack8(r[2 * j + 1], ac); const float m = (t - 2 + j >= 0) ? 1.f : 0.f;
#pragma unroll
        for (int i = 0; i < 8; ++i) u[j][i] = ah[i] * ac[i] * m; }
    float ab[8], ag[8]; unpack8(r[6], ab); unpack8(r[7], ag);
    float w0[8], w1[8], w2[8];
    { const float4 a0 = *(const float4*)(cw + c), a1 = *(const float4*)(cw + c + 4), b0 = *(const float4*)(cw + 256 + c), b1 = *(const float4*)(cw + 256 + c + 4), c0 = *(const float4*)(cw + 512 + c), c1 = *(const float4*)(cw + 512 + c + 4);
      w0[0] = a0.x; w0[1] = a0.y; w0[2] = a0.z; w0[3] = a0.w; w0[4] = a1.x; w0[5] = a1.y; w0[6] = a1.z; w0[7] = a1.w;
      w1[0] = b0.x; w1[1] = b0.y; w1[2] = b0.z; w1[3] = b0.w; w1[4] = b1.x; w1[5] = b1.y; w1[6] = b1.z; w1[7] = b1.w;
      w2[0] = c0.x; w2[1] = c0.y; w2[2] = c0.z; w2[3] = c0.w; w2[4] = c1.x; w2[5] = c1.y; w2[6] = c1.z; w2[7] = c1.w; }
    float o[8];
#pragma unroll
    for (int i = 0; i < 8; ++i) { const float y = w0[i] * u[0][i] + w1[i] * u[1][i] + w2[i] * u[2][i]; o[i] = ab[i] * y * silu(ag[i]); }
    u32x4 w; w.x = pk2(o[0], o[1]); w.y = pk2(o[2], o[3]); w.z = pk2(o[4], o[5]); w.w = pk2(o[6], o[7]);
    *(u32x4*)((bf16_t*)(p.ws + WS_XB) + (size_t)row * DM + c) = w;
    if (t >= 2046) { float* d = p.out + O_NCP + (size_t)(l * 8 + (row >> 11)) * 512 + (t - 2046) * 256 + c; *(float4*)d = make_float4(u[2][0], u[2][1], u[2][2], u[2][3]); *(float4*)(d + 4) = make_float4(u[2][4], u[2][5], u[2][6], u[2][7]); }
}
DI void phase_conv_prompt(const Params& p, int l, int idx_lo, int idx_hi, int stride) {
    const bf16_t* z = (const bf16_t*)(p.ws + WS_Z);
    for (int idx = idx_lo + ltid(); idx < idx_hi; idx += 2 * stride) {
        u32x4 ra[8], rb[8]; const bool two = idx + stride < idx_hi;
        conv_ld(z, idx, ra); conv_ld(z, two ? idx + stride : idx, rb);
        conv_fin(p, l, idx, ra); if (two) conv_fin(p, l, idx + stride, rb);
    }
}

DI void pool_ld(const bf16_t* z, int tile, int tid, u32x4 (&vld)[3], u32x4 (&gld)[2]) {
    const int row0 = tile * 32, t0 = row0 & 2047;
#pragma unroll
    for (int k = 0; k < 3; ++k) { const int it = tid + k * NT, rr = it >> 5, c = (it & 31) * 8; vld[k] = (u32x4){0u, 0u, 0u, 0u};
        if (it < 47 * 32 && t0 - 15 + rr >= 0) vld[k] = *(const u32x4*)(z + (size_t)(row0 - 15 + rr) * DIN + C_PV + c); }
#pragma unroll
    for (int k = 0; k < 2; ++k) { const int it = tid + k * NT, tl = it >> 5, c = (it & 31) * 8; gld[k] = *(const u32x4*)(z + (size_t)(row0 + tl) * DIN + C_PG + c); }
}
DI void phase_pool(const Params& p, int l, unsigned char* lds, int tile_lo, int tile_hi, int blk, int nblk, bool do_bufs, bool setup = true) {
    const int tid = ltid(), wid = tid >> 6, lane = tid & 63, lr = lane & 15, lq = lane >> 4;
    const bf16_t* z = (const bf16_t*)(p.ws + WS_Z); bf16_t* mix = (bf16_t*)(p.ws + WS_XB);
    constexpr int P_PWT = 0, P_UB = 36864, P_GT = 53760, P_OB = 87040, P_VT = 103936;
    float* gt = (float*)(lds + P_GT);
    __syncthreads();
    if (setup) { const float* pw = p.pool_w + (size_t)l * 16384;
      for (int i = tid; i < 16384; i += NT) { const int g = i >> 12, c = (i >> 6) & 63, d = i & 63; *(bf16_t*)(lds + P_PWT + (g * 64 + d) * 144 + c * 2) = f2bf(pw[i]); } }
    u32x4 vld[3], gld[2];
    if (tile_lo + blk < tile_hi && tile_lo + blk < 512) pool_ld(z, tile_lo + blk, tid, vld, gld);
    for (int tile = tile_lo + blk; tile < tile_hi; tile += nblk) {
        __syncthreads();
        if (tile < 512) {
            const int row0 = tile * 32, t0 = row0 & 2047;
#pragma unroll
            for (int k = 0; k < 3; ++k) { const int it = tid + k * NT, rr = it >> 5, c = (it & 31) * 8; if (it < 47 * 32) *(u32x4*)(lds + P_VT + rr * 528 + c * 2) = vld[k]; }
#pragma unroll
            for (int k = 0; k < 2; ++k) { const int it = tid + k * NT, tl = it >> 5, c = (it & 31) * 8;
                float g[8]; unpack8(gld[k], g);
                const float4 s0 = *(const float4*)(p.pool_scale + l * 256 + c), s1 = *(const float4*)(p.pool_scale + l * 256 + c + 4);
                *(float4*)(gt + tl * 260 + c) = make_float4(s0.x * silu(g[0]), s0.y * silu(g[1]), s0.z * silu(g[2]), s0.w * silu(g[3]));
                *(float4*)(gt + tl * 260 + c + 4) = make_float4(s1.x * silu(g[4]), s1.y * silu(g[5]), s1.z * silu(g[6]), s1.w * silu(g[7])); }
            if (tile + nblk < tile_hi && tile + nblk < 512) pool_ld(z, tile + nblk, tid, vld, gld);
            __syncthreads();
#pragma unroll
            for (int k = 0; k < 2; ++k) { const int it = tid + k * NT, tl = it >> 5, c = (it & 31) * 8, gi = c >> 6, w = 2 << gi;
                float s[8], cur[8];
                unpack8(*(const u32x4*)(lds + P_VT + (tl + 15) * 528 + c * 2), cur);
#pragma unroll
                for (int i = 0; i < 8; ++i) s[i] = cur[i];
                for (int j = 1; j < w; ++j) { float v[8]; unpack8(*(const u32x4*)(lds + P_VT + (tl + 15 - j) * 528 + c * 2), v);
#pragma unroll
                    for (int i = 0; i < 8; ++i) s[i] += v[i]; }
                const float inv = frcp((float)min(w, t0 + tl + 1));
                u32x4 uw; uw.x = pk2(s[0] * inv - cur[0], s[1] * inv - cur[1]); uw.y = pk2(s[2] * inv - cur[2], s[3] * inv - cur[3]);
                uw.z = pk2(s[4] * inv - cur[4], s[5] * inv - cur[5]); uw.w = pk2(s[6] * inv - cur[6], s[7] * inv - cur[7]);
                *(u32x4*)(lds + P_UB + tl * 528 + c * 2) = uw; }
        } else {
            for (int it = tid; it < 1024; it += NT) {
                const int tl = it >> 5, c = (it & 31) * 8, gi = c >> 6, w = 2 << gi;
                const int row = MP + (tile - 512) * 32 + tl, rr = row - MP, t = rr & 3; const float* buf = p.state_pool + (size_t)(l * 128 + (rr >> 2)) * 15 * 256;
                float s[8], cur[8];
                unpack8(*(const u32x4*)(z + (size_t)row * DIN + C_PV + c), cur);
#pragma unroll
                for (int i = 0; i < 8; ++i) s[i] = cur[i];
#pragma unroll
                for (int j = 1; j < 4; ++j) { float v[8]; unpack8(*(const u32x4*)(z + (size_t)(row - min(j, t)) * DIN + C_PV + c), v); const float m = (j <= t && j < w) ? 1.f : 0.f;
#pragma unroll
                    for (int i = 0; i < 8; ++i) s[i] += m * v[i]; }
#pragma unroll
                for (int j = 1; j < 16; ++j) { const int tp = t - j, bi = tp < 0 ? 15 + tp : 0; const float m = (tp < 0 && j < w) ? 1.f : 0.f;
                    const float4 a = *(const float4*)(buf + bi * 256 + c), b4 = *(const float4*)(buf + bi * 256 + c + 4);
                    s[0] += m * a.x; s[1] += m * a.y; s[2] += m * a.z; s[3] += m * a.w; s[4] += m * b4.x; s[5] += m * b4.y; s[6] += m * b4.z; s[7] += m * b4.w; }
                const float inv = frcp((float)w);
                u32x4 uw; uw.x = pk2(s[0] * inv - cur[0], s[1] * inv - cur[1]); uw.y = pk2(s[2] * inv - cur[2], s[3] * inv - cur[3]);
                uw.z = pk2(s[4] * inv - cur[4], s[5] * inv - cur[5]); uw.w = pk2(s[6] * inv - cur[6], s[7] * inv - cur[7]);
                *(u32x4*)(lds + P_UB + tl * 528 + c * 2) = uw;
                float g[8]; unpack8(*(const u32x4*)(z + (size_t)row * DIN + C_PG + c), g);
                const float4 s0 = *(const float4*)(p.pool_scale + l * 256 + c), s1 = *(const float4*)(p.pool_scale + l * 256 + c + 4);
                *(float4*)(gt + tl * 260 + c) = make_float4(s0.x * silu(g[0]), s0.y * silu(g[1]), s0.z * silu(g[2]), s0.w * silu(g[3]));
                *(float4*)(gt + tl * 260 + c + 4) = make_float4(s1.x * silu(g[4]), s1.y * silu(g[5]), s1.z * silu(g[6]), s1.w * silu(g[7]));
            }
        }
        __syncthreads();
        { const int gi = wid >> 1, tt = wid & 1;
          f32x4 acc[4];
#pragma unroll
          for (int n = 0; n < 4; ++n) acc[n] = (f32x4){0.f, 0.f, 0.f, 0.f};
#pragma unroll
          for (int ks = 0; ks < 2; ++ks) { const bf16x8 a = *(const bf16x8*)(lds + P_UB + (tt * 16 + lr) * 528 + (gi * 64 + ks * 32 + lq * 8) * 2);
#pragma unroll
              for (int n = 0; n < 4; ++n) { const bf16x8 bb = *(const bf16x8*)(lds + P_PWT + (gi * 64 + n * 16 + lr) * 144 + (ks * 32 + lq * 8) * 2);
                  acc[n] = __builtin_amdgcn_mfma_f32_16x16x32_bf16(a, bb, acc[n], 0, 0, 0); } }
#pragma unroll
          for (int n = 0; n < 4; ++n)
#pragma unroll
              for (int j = 0; j < 4; ++j) { const int t = tt * 16 + lq * 4 + j, ch = gi * 64 + n * 16 + lr;
                  *(bf16_t*)(lds + P_OB + t * 528 + ch * 2) = f2bf(acc[n][j] * gt[t * 260 + ch]); } }
        __syncthreads();
        for (int it = tid; it < 1024; it += NT) { const int tl = it >> 5, c = (it & 31) * 8;
            const int row = tile < 512 ? tile * 32 + tl : MP + (tile - 512) * 32 + tl;
            *(u32x4*)(mix + (size_t)row * DM + 768 + c) = *(const u32x4*)(lds + P_OB + tl * 528 + c * 2); }
    }
    if (do_bufs)
    for (int idx = blk * NT + tid; idx < 136 * 15 * 32; idx += nblk * NT) {
        const int c = (idx & 31) * 8, r = idx >> 5, j = r % 15, bg = r / 15;
        float v[8]; float* dst;
        if (bg < 8) { unpack8(*(const u32x4*)(z + (size_t)(bg * 2048 + 2048 - 15 + j) * DIN + C_PV + c), v); dst = p.out + O_NPP + (size_t)((l * 8 + bg) * 15 + j) * 256 + c; }
        else { const int b = bg - 8, tp = j - 11; dst = p.out + O_NPS + (size_t)((l * 128 + b) * 15 + j) * 256 + c;
            if (tp < 0) { const float* sp = p.state_pool + (size_t)((l * 128 + b) * 15 + j + 4) * 256 + c; const float4 a = *(const float4*)sp, b4 = *(const float4*)(sp + 4);
                v[0] = a.x; v[1] = a.y; v[2] = a.z; v[3] = a.w; v[4] = b4.x; v[5] = b4.y; v[6] = b4.z; v[7] = b4.w; }
            else unpack8(*(const u32x4*)(z + (size_t)(MP + b * 4 + tp) * DIN + C_PV + c), v); }
        *(float4*)dst = make_float4(v[0], v[1], v[2], v[3]); *(float4*)(dst + 4) = make_float4(v[4], v[5], v[6], v[7]);
    }
    __syncthreads();
}

DI float lb_of(const Params& p, int l, int d) {
    if (l == 0) return 0.f;
    const float a0 = p.hgrn_lb[d], a1 = p.hgrn_lb[512 + d];
    return frcp(1.0f + __expf(a0 - a1));
}
DI void gate_fk(float x, float lb, float& f, float& k) {
    x = fminf(fmaxf(x, -30.f), 30.f);
    const float e = __expf(-x), sig = frcp(1.0f + e);
    f = lb + (1.0f - lb) * sig; k = (1.0f - lb) * (e * sig);
}

struct ChunkRaw { unsigned f[8], v[8], q[8]; u32x4 qm[2], km[2]; bf16x8 bS[4]; u32x2 g[4]; };
template <bool PASSC>
DI void chunk_load(ChunkRaw& r, const Params& p, int ch, int tid) {
    const int dp = tid & 63, wid = tid >> 6, lane = tid & 63, lr = lane & 15, lq = lane >> 4;
    const int b = ch >> 7, h = (ch >> 5) & 3, c = ch & 31, r0 = b * 2048 + c * 64;
    const bf16_t* z = (const bf16_t*)(p.ws + WS_Z);
    const bf16_t* S16 = (const bf16_t*)(p.ws + WS_U + 33554432) + (size_t)ch * 16384;
    const bf16_t* zrow = z + (size_t)(r0 + wid * 8) * DIN + h * 128 + 2 * dp;
    if (!PASSC) {
#pragma unroll
        for (int i = 0; i < 8; ++i) r.f[i] = *(const unsigned*)(zrow + (size_t)i * DIN + C_F);
#pragma unroll
        for (int i = 0; i < 8; ++i) r.q[i] = *(const unsigned*)(zrow + (size_t)i * DIN + C_Q);
    } else {
#pragma unroll
        for (int k = 0; k < 2; ++k) { const int u = tid + k * NT; const bf16_t* zr = z + (size_t)(r0 + (u >> 4)) * DIN + h * 128 + (u & 15) * 8;
            r.qm[k] = *(const u32x4*)(zr + C_Q); r.km[k] = *(const u32x4*)(zr + C_F); }
    }
#pragma unroll
    for (int i = 0; i < 8; ++i) r.v[i] = *(const unsigned*)(zrow + (size_t)i * DIN + C_I);
    if (PASSC) {
#pragma unroll
        for (int ks = 0; ks < 4; ++ks) r.bS[ks] = *(const bf16x8*)(S16 + (size_t)(wid * 16 + lr) * 128 + ks * 32 + lq * 8);
#pragma unroll
        for (int tt = 0; tt < 4; ++tt) r.g[tt] = *(const u32x2*)(z + (size_t)(r0 + tt * 16 + lr) * DIN + C_GB + h * 128 + wid * 16 + lq * 4);
    }
}
template <bool PASSC>
DI void hgrn_chunk(const ChunkRaw& raw, const Params& p, int l, int ch, unsigned char* lds, int tid) {
    const int dp = tid & 63, wid = tid >> 6, lane = tid & 63, lr = lane & 15, lq = lane >> 4, d0 = 2 * dp;
    const int b = ch >> 7, h = (ch >> 5) & 3, c = ch & 31, r0 = b * 2048 + c * 64;
    bf16_t* U16 = (bf16_t*)(p.ws + WS_U) + (size_t)ch * 16384;
    float* tot = (float*)(lds + L_TOT); float* eb = (float*)(lds + L_EB);
    const float lb0 = lb_of(p, l, h * 128 + d0), lb1 = lb_of(p, l, h * 128 + d0 + 1);
    const bf16x8 (&bS)[4] = raw.bS; const u32x2 (&graw)[4] = raw.g;
    float cs0[8], cs1[8], kk0[8], kk1[8]; float off0 = 0.f, off1 = 0.f, bref0 = 0.f, bref1 = 0.f, bL0 = 0.f, bL1 = 0.f;
    if (!PASSC) {
        float cum0 = 0.f, cum1 = 0.f;
#pragma unroll
        for (int i = 0; i < 8; ++i) { float f, k; gate_fk(__uint_as_float(raw.f[i] << 16), lb0, f, k); cum0 += __logf(f); cs0[i] = cum0; kk0[i] = k;
            gate_fk(__uint_as_float(raw.f[i] & 0xffff0000u), lb1, f, k); cum1 += __logf(f); cs1[i] = cum1; kk1[i] = k; }
        *(float2*)(tot + wid * 128 + d0) = make_float2(cum0, cum1);
        __syncthreads();
#pragma unroll
        for (int sgm = 0; sgm < 8; ++sgm) { const float2 tv = *(const float2*)(tot + sgm * 128 + d0);
            if (sgm < wid) { off0 += tv.x; off1 += tv.y; } if (sgm < 4) { bref0 += tv.x; bref1 += tv.y; } bL0 += tv.x; bL1 += tv.y; }
    }
    { u32x4 w0, w1;
#pragma unroll
      for (int j = 0; j < 4; ++j) { w0[j] = (raw.v[2 * j] & 0xffffu) | (raw.v[2 * j + 1] << 16); w1[j] = (raw.v[2 * j] >> 16) | (raw.v[2 * j + 1] & 0xffff0000u); }
      *(u32x4*)(lds + L_VT + d0 * 144 + wid * 16) = w0; *(u32x4*)(lds + L_VT + (d0 + 1) * 144 + wid * 16) = w1; }
    if (!PASSC) {
        float km0[8], km1[8];
        { bf16_t* zw = (bf16_t*)(p.ws + WS_Z) + (size_t)(r0 + wid * 8) * DIN + h * 128 + d0;
#pragma unroll
          for (int i = 0; i < 8; ++i) { const float b0 = fminf(fmaxf(off0 + cs0[i] - bref0, -80.f), 80.f), b1 = fminf(fmaxf(off1 + cs1[i] - bref1, -80.f), 80.f); const float e0 = __expf(b0), e1 = __expf(b1);
              km0[i] = kk0[i] * frcp(e0); km1[i] = kk1[i] * frcp(e1);
              *(unsigned*)(zw + (size_t)i * DIN + C_Q) = pk2(__uint_as_float(raw.q[i] << 16) * e0, __uint_as_float(raw.q[i] & 0xffff0000u) * e1);
              *(unsigned*)(zw + (size_t)i * DIN + C_F) = pk2(km0[i], km1[i]); } }
        u32x4 w0, w1;
#pragma unroll
        for (int j = 0; j < 4; ++j) { w0[j] = pk2(km0[2 * j], km0[2 * j + 1]); w1[j] = pk2(km1[2 * j], km1[2 * j + 1]); }
        *(u32x4*)(lds + L_ST + d0 * 144 + wid * 16) = w0; *(u32x4*)(lds + L_ST + (d0 + 1) * 144 + wid * 16) = w1;
        if (wid == 0) { *(float2*)((float*)(p.ws + WS_DEC) + (size_t)ch * 128 + d0) = make_float2(__expf(bL0), __expf(bL1));
            *(float2*)((float*)(p.ws + WS_EBR) + (size_t)ch * 128 + d0) = make_float2(__expf(bref0), __expf(bref1));
            *(float2*)(eb + d0) = make_float2(__expf(bL0 - bref0), __expf(bL1 - bref1)); }
        __syncthreads();
        f32x4 acc[8];
#pragma unroll
        for (int n = 0; n < 8; ++n) acc[n] = (f32x4){0.f, 0.f, 0.f, 0.f};
#pragma unroll
        for (int ks = 0; ks < 2; ++ks) {
            const bf16x8 bv = *(const bf16x8*)(lds + L_VT + (wid * 16 + lr) * 144 + (ks * 32 + lq * 8) * 2);
#pragma unroll
            for (int n = 0; n < 8; ++n) { const bf16x8 ak = *(const bf16x8*)(lds + L_ST + (n * 16 + lr) * 144 + (ks * 32 + lq * 8) * 2);
                acc[n] = __builtin_amdgcn_mfma_f32_16x16x32_bf16(ak, bv, acc[n], 0, 0, 0); }
        }
#pragma unroll
        for (int n = 0; n < 8; ++n) { const float4 sc = *(const float4*)(eb + n * 16 + lq * 4);
            u32x2 w2; w2.x = pk2(acc[n][0] * sc.x, acc[n][1] * sc.y); w2.y = pk2(acc[n][2] * sc.z, acc[n][3] * sc.w);
            *(u32x2*)(U16 + (size_t)(wid * 16 + lr) * 128 + n * 16 + lq * 4) = w2; }
        __syncthreads();
    } else {
#pragma unroll
        for (int k = 0; k < 2; ++k) { const int u = tid + k * NT; *(u32x4*)(lds + L_QM + (u >> 4) * 272 + (u & 15) * 16) = raw.qm[k]; *(u32x4*)(lds + L_KM + (u >> 4) * 272 + (u & 15) * 16) = raw.km[k]; }
        __syncthreads();
        { const int tt = wid >> 1;
#pragma unroll
          for (int jj = 0; jj < 2; ++jj) {
            const int st = (wid & 1) * 2 + jj; f32x4 acc = (f32x4){0.f, 0.f, 0.f, 0.f};
            if (st <= tt) {
#pragma unroll
                for (int ks = 0; ks < 4; ++ks) { const bf16x8 a = *(const bf16x8*)(lds + L_QM + (tt * 16 + lr) * 272 + (ks * 32 + lq * 8) * 2);
                    const bf16x8 bb = *(const bf16x8*)(lds + L_KM + (st * 16 + lr) * 272 + (ks * 32 + lq * 8) * 2);
                    acc = __builtin_amdgcn_mfma_f32_16x16x32_bf16(a, bb, acc, 0, 0, 0); }
            }
#pragma unroll
            for (int j = 0; j < 4; ++j) { const int t = tt * 16 + lq * 4 + j, s = st * 16 + lr;
                *(bf16_t*)(lds + L_AM + t * 144 + s * 2) = f2bf(s <= t ? acc[j] : 0.f); }
          } }
        __syncthreads();
        f32x4 acc[4];
        bf16x8 bV[2];
#pragma unroll
        for (int ks = 0; ks < 2; ++ks) bV[ks] = *(const bf16x8*)(lds + L_VT + (wid * 16 + lr) * 144 + (ks * 32 + lq * 8) * 2);
#pragma unroll
        for (int tt = 0; tt < 4; ++tt) {
            acc[tt] = (f32x4){0.f, 0.f, 0.f, 0.f};
#pragma unroll
            for (int ks = 0; ks < 4; ++ks) { const bf16x8 q = *(const bf16x8*)(lds + L_QM + (tt * 16 + lr) * 272 + (ks * 32 + lq * 8) * 2);
                acc[tt] = __builtin_amdgcn_mfma_f32_16x16x32_bf16(bS[ks], q, acc[tt], 0, 0, 0); }
#pragma unroll
            for (int ks = 0; ks < 2; ++ks) { if (ks * 32 <= tt * 16 + 15) { const bf16x8 am = *(const bf16x8*)(lds + L_AM + (tt * 16 + lr) * 144 + (ks * 32 + lq * 8) * 2);
                acc[tt] = __builtin_amdgcn_mfma_f32_16x16x32_bf16(bV[ks], am, acc[tt], 0, 0, 0); } }
        }
        float* ssq = (float*)(lds + L_ST);
#pragma unroll
        for (int tt = 0; tt < 4; ++tt) { float ss = acc[tt][0] * acc[tt][0] + acc[tt][1] * acc[tt][1] + acc[tt][2] * acc[tt][2] + acc[tt][3] * acc[tt][3];
            ss += __shfl_xor(ss, 16, 64); ss += __shfl_xor(ss, 32, 64);
            if (lq == 0) ssq[(tt * 16 + lr) * 8 + wid] = ss; }
        __syncthreads();
        bf16_t* mix = (bf16_t*)(p.ws + WS_XB);
        const float4 ng = *(const float4*)(p.hgrn_norm_g + l * 512 + h * 128 + wid * 16 + lq * 4);
#pragma unroll
        for (int tt = 0; tt < 4; ++tt) { const int t = tt * 16 + lr;
            const float4 s0 = *(const float4*)(ssq + t * 8), s1 = *(const float4*)(ssq + t * 8 + 4);
            const float rs = rsqrtf((s0.x + s0.y + s0.z + s0.w + s1.x + s1.y + s1.z + s1.w) * (1.0f / 128.0f) + EPS);
            const float g0 = __uint_as_float(graw[tt].x << 16), g1 = __uint_as_float(graw[tt].x & 0xffff0000u), g2 = __uint_as_float(graw[tt].y << 16), g3 = __uint_as_float(graw[tt].y & 0xffff0000u);
            u32x2 w2; w2.x = pk2(acc[tt][0] * rs * ng.x * silu(g0), acc[tt][1] * rs * ng.y * silu(g1)); w2.y = pk2(acc[tt][2] * rs * ng.z * silu(g2), acc[tt][3] * rs * ng.w * silu(g3));
            *(u32x2*)(mix + (size_t)(r0 + t) * DM + 256 + h * 128 + wid * 16 + lq * 4) = w2; }
        __syncthreads();
    }
}

template <bool PASSC>
DI void hgrn_pass(const Params& p, int l, unsigned char* lds) {
    const int tid = ltid();
    if (PASSC_PREFETCH || !PASSC) {
        ChunkRaw ra, rb;
        chunk_load<PASSC>(ra, p, (int)blockIdx.x, tid);
        chunk_load<PASSC>(rb, p, (int)blockIdx.x + GRID, tid);
        hgrn_chunk<PASSC>(ra, p, l, (int)blockIdx.x, lds, tid);
        chunk_load<PASSC>(ra, p, (int)blockIdx.x + 2 * GRID, tid);
        hgrn_chunk<PASSC>(rb, p, l, (int)blockIdx.x + GRID, lds, tid);
        chunk_load<PASSC>(rb, p, (int)blockIdx.x + 3 * GRID, tid);
        hgrn_chunk<PASSC>(ra, p, l, (int)blockIdx.x + 2 * GRID, lds, tid);
        hgrn_chunk<PASSC>(rb, p, l, (int)blockIdx.x + 3 * GRID, lds, tid);
    } else {
        for (int k = 0; k < 4; ++k) { ChunkRaw ra; chunk_load<PASSC>(ra, p, (int)blockIdx.x + k * GRID, tid); hgrn_chunk<PASSC>(ra, p, l, (int)blockIdx.x + k * GRID, lds, tid); }
    }
}

DI void phase_scan(const Params& p, int l, int idx_lo, int idx_hi, int stride) {
    const bf16_t* U16 = (const bf16_t*)(p.ws + WS_U); bf16_t* S16 = (bf16_t*)(p.ws + WS_U + 33554432);
    const float* dec = (const float*)(p.ws + WS_DEC); const float* ebr = (const float*)(p.ws + WS_EBR);
    for (int idx = idx_lo + ltid(); idx < idx_hi; idx += stride) {
        const int d4 = (idx & 31) * 4, e = (idx >> 5) & 127, bh = idx >> 12;
        float4 s = make_float4(0.f, 0.f, 0.f, 0.f);
        const size_t o0 = (size_t)bh * 32 * 16384 + e * 128 + d4; const float* pd0 = dec + (size_t)bh * 32 * 128 + d4; const float* pe0 = ebr + (size_t)bh * 32 * 128 + d4;
        for (int cb = 0; cb < 32; cb += 8) {
            u32x2 u[8]; float4 dc[8], ee[8];
#pragma unroll
            for (int j = 0; j < 8; ++j) { u[j] = *(const u32x2*)(U16 + o0 + (size_t)(cb + j) * 16384); dc[j] = *(const float4*)(pd0 + (cb + j) * 128); ee[j] = *(const float4*)(pe0 + (cb + j) * 128); }
#pragma unroll
            for (int j = 0; j < 8; ++j) { u32x2 w2; w2.x = pk2(s.x * ee[j].x, s.y * ee[j].y); w2.y = pk2(s.z * ee[j].z, s.w * ee[j].w);
                *(u32x2*)(S16 + o0 + (size_t)(cb + j) * 16384) = w2;
                s.x = dc[j].x * s.x + __uint_as_float(u[j].x << 16); s.y = dc[j].y * s.y + __uint_as_float(u[j].x & 0xffff0000u);
                s.z = dc[j].z * s.z + __uint_as_float(u[j].y << 16); s.w = dc[j].w * s.w + __uint_as_float(u[j].y & 0xffff0000u); }
        }
        float* o = p.out + O_NHP + (size_t)(l * 32 + bh) * 16384 + e;
        o[(d4 + 0) * 128] = s.x; o[(d4 + 1) * 128] = s.y; o[(d4 + 2) * 128] = s.z; o[(d4 + 3) * 128] = s.w;
    }
}

DI void sample_ld(const Params& p, int l, int item, int tid, float4 (&S)[8], bf16_t (&zs)[5]) {
    const int b = item >> 2, h = item & 3, e4 = (tid & 31) * 4, dg = tid >> 5;
    const float* S0 = p.state_hgrn + (size_t)((l * 128 + b) * 4 + h) * 16384;
    { const bf16_t* zr = (const bf16_t*)(p.ws + WS_Z) + (size_t)(MP + b * 4 + (tid >> 7)) * DIN + h * 128 + (tid & 127); zs[0] = zr[C_F]; zs[1] = zr[C_Q]; zs[2] = zr[C_I]; zs[3] = zr[C_GB]; zs[4] = 0; }
#pragma unroll
    for (int i = 0; i < 8; ++i) S[i] = ldnt4(S0 + (size_t)(dg + 16 * i) * 128 + e4);
}
DI void hgrn_sample(const Params& p, int l, int item, unsigned char* lds, int tid, float4 (&S)[8], const bf16_t (&zs)[5]) {
    const int b = item >> 2, h = item & 3, wid = tid >> 6, lane = tid & 63;
    const bf16_t* z = (const bf16_t*)(p.ws + WS_Z);
    float* sf = (float*)lds; float* sk = sf + 512; float* sq = sk + 512; float* sv = sq + 512; float* sg = sv + 512; float* red = sg + 512; float* ssq = red + 8192;
    { const int d = tid & 127;
      float f, k; gate_fk(bf2f(zs[0]), lb_of(p, l, h * 128 + d), f, k);
      sf[tid] = f; sk[tid] = k; sq[tid] = bf2f(zs[1]); sv[tid] = bf2f(zs[2]); sg[tid] = bf2f(zs[3]); }
    const int e4 = (tid & 31) * 4, dg = tid >> 5;
    float* S1 = p.out + O_NHS + (size_t)((l * 128 + b) * 4 + h) * 16384;
    __syncthreads();
#pragma unroll
    for (int t = 0; t < 4; ++t) {
        const float4 v = *(const float4*)(sv + t * 128 + e4); float4 a = make_float4(0.f, 0.f, 0.f, 0.f);
#pragma unroll
        for (int i = 0; i < 8; ++i) { const int d = t * 128 + dg + 16 * i; const float f = sf[d], k = sk[d], q = sq[d];
            S[i].x = f * S[i].x + k * v.x; S[i].y = f * S[i].y + k * v.y; S[i].z = f * S[i].z + k * v.z; S[i].w = f * S[i].w + k * v.w;
            a.x += q * S[i].x; a.y += q * S[i].y; a.z += q * S[i].z; a.w += q * S[i].w; }
        *(float4*)(red + (t * 16 + dg) * 128 + e4) = a;
    }
#pragma unroll
    for (int i = 0; i < 8; ++i) stnt4(S1 + (size_t)(dg + 16 * i) * 128 + e4, S[i]);
    __syncthreads();
    { const int t = tid >> 7, e = tid & 127; float o = 0.f;
#pragma unroll
      for (int g = 0; g < 16; ++g) o += red[(t * 16 + g) * 128 + e];
      const float ss = wave_sum(o * o);
      if (lane == 0) ssq[wid] = ss;
      __syncthreads();
      const float rs = rsqrtf((ssq[2 * t] + ssq[2 * t + 1]) * (1.0f / 128.0f) + EPS);
      ((bf16_t*)(p.ws + WS_XB))[(size_t)(MP + b * 4 + t) * DM + 256 + h * 128 + e] = f2bf(o * rs * p.hgrn_norm_g[l * 512 + h * 128 + e] * silu(sg[tid])); }
    __syncthreads();
}
DI void phase_sample(const Params& p, int l, unsigned char* lds) {
    const int tid = ltid(), bk = (int)blockIdx.x; float4 Sa[8], Sb[8]; bf16_t za[5], zb[5];
    sample_ld(p, l, bk, tid, Sa, za);
    if (bk >= 16) sample_ld(p, l, bk + GRID, tid, Sb, zb);
    hgrn_sample(p, l, bk, lds, tid, Sa, za);
    if (bk >= 32 && bk < 48) sample_ld(p, l, bk - 32 + GRID, tid, Sa, za);
    if (bk >= 16) hgrn_sample(p, l, bk + GRID, lds, tid, Sb, zb);
    if (bk >= 32 && bk < 48) hgrn_sample(p, l, bk - 32 + GRID, lds, tid, Sa, za);
}

DI void phase_p2(const Params& p, int l, unsigned char* lds) {
    const int tid = ltid(), bk = (int)blockIdx.x;
    ChunkRaw ra, rb; float4 Sa[8], Sb[8]; bf16_t za[5], zb[5];
    chunk_load<false>(ra, p, bk, tid);
    chunk_load<false>(rb, p, bk + GRID, tid);
    hgrn_chunk<false>(ra, p, l, bk, lds, tid);
    chunk_load<false>(ra, p, bk + 2 * GRID, tid);
    hgrn_chunk<false>(rb, p, l, bk + GRID, lds, tid);
    chunk_load<false>(rb, p, bk + 3 * GRID, tid);
    hgrn_chunk<false>(ra, p, l, bk + 2 * GRID, lds, tid);
    sample_ld(p, l, bk, tid, Sa, za);
    hgrn_chunk<false>(rb, p, l, bk + 3 * GRID, lds, tid);
    if (bk >= 16) sample_ld(p, l, bk + GRID, tid, Sb, zb);
    hgrn_sample(p, l, bk, lds, tid, Sa, za);
    if (bk >= 32 && bk < 48) sample_ld(p, l, bk - 32 + GRID, tid, Sa, za);
    if (bk >= 16) hgrn_sample(p, l, bk + GRID, lds, tid, Sb, zb);
    if (bk >= 32 && bk < 48) hgrn_sample(p, l, bk - 32 + GRID, lds, tid, Sa, za);
}

DI Params load_params() {
    Params p{};
#if defined(__HIP_DEVICE_COMPILE__)
    typedef const __attribute__((address_space(4))) Params* KParams;
    KParams kp = (KParams)__builtin_amdgcn_kernarg_segment_ptr(); asm volatile("" : "+s"(kp));
    p.x_prompt = kp->x_prompt; p.x_sample = kp->x_sample; p.state_conv = kp->state_conv; p.state_hgrn = kp->state_hgrn; p.state_pool = kp->state_pool; p.norm_g = kp->norm_g; p.w_in = kp->w_in;
    p.conv_w = kp->conv_w; p.hgrn_lb = kp->hgrn_lb; p.hgrn_norm_g = kp->hgrn_norm_g; p.pool_w = kp->pool_w; p.pool_scale = kp->pool_scale; p.w_out = kp->w_out; p.final_norm_g = kp->final_norm_g;
    p.out = kp->out; p.ws = kp->ws;
#endif
    return p;
}
#define LP() load_params()
__global__ __launch_bounds__(512, 2) void hymba_fwd(Params p_unused) {
    extern __shared__ __attribute__((aligned(16))) unsigned char shm[];
    cg::grid_group grid = cg::this_grid();
    volatile LAS unsigned* xst = (volatile LAS unsigned*)(shm + 131072);
    if (threadIdx.x == 0) { xst[0] = 0u; xst[1] = 0u; xst[2] = 0u; xst[3] = 0u; }
    __syncthreads();
    { const Params p = LP(); (void)xcd_barrier_post((unsigned*)(p.ws + WS_BAR), xst); }
#define GSYNC() do { const Params p_ = LP(); XcdBarrier b_; b_.bar = (unsigned*)(p_.ws + WS_BAR); b_.x = xb_xcc_id(); b_.st = xst; xcd_barrier(b_); } while (0)
    { const Params p = LP(); phase_weights(p, shm, 0, 896, (int)blockIdx.x, (int)gridDim.x); }
    { const Params p = LP(); phase_norm0(p); }
    { const Params p = LP(); if (p.ws == nullptr) grid.sync(); }
    GSYNC();
    for (int l = 0; l < 2; ++l) {
        { const Params p = LP(); pg8::Gemm g; g.A = (const bf16_t*)(p.ws + (l == 0 ? WS_XB : WS_U)); g.Bt = (const bf16_t*)(p.ws + WS_WIN) + (size_t)l * DIN * DM; g.M = MT; g.N = DIN; g.K = DM;
          pg8::StaticOrder S; S.init(MT, DIN, (int)gridDim.x, (int)blockIdx.x); EpiZ E; E.O = (bf16_t*)(p.ws + WS_Z); E.ssq = l == 0 ? nullptr : (const float*)(p.ws + WS_SSQ) + (size_t)l * MT;
          pg8::gemm_phase<EpiZ, pg8::StaticOrder, false>((PG8_LAS unsigned char*)shm, g, S, E, nullptr);
        }
        if (blockIdx.x >= 156) { const Params p = LP(); phase_weights(p, shm, l == 0 ? 896 : 2048, l == 0 ? 2048 : 2304, (int)blockIdx.x - 156, (int)gridDim.x - 156); }
        GSYNC();
        { const Params p = LP(); phase_p2(p, l, shm); }
        if (blockIdx.x >= 48 && blockIdx.x < 80) { const Params p = LP(); phase_conv(p, l, MP, MT, (int)blockIdx.x - 48, 32); }
        { const Params p = LP(); if (blockIdx.x < 16) phase_pool(p, l, shm, 512, 528, (int)blockIdx.x, 16, false); }
        GSYNC();
        if (blockIdx.x < 8) { const Params p = LP(); float* xs = p.out + O_Y + (size_t)MP * DM; pg8::Gemm g; g.A = (const bf16_t*)(p.ws + WS_XB) + (size_t)MP * DM; g.Bt = (const bf16_t*)(p.ws + WS_WOUT) + (size_t)l * DM * DM; g.M = MS; g.N = DM; g.K = DM;
          pg8::StaticOrder S; S.init(MS, DM, (int)gridDim.x, (int)blockIdx.x); EpiRes E; E.X = xs; E.src = l == 0 ? p.x_sample : xs; E.ssq = (float*)(p.ws + WS_SSQ) + (size_t)(l + 1) * MT + MP; E.xbn = l == 0 ? (bf16_t*)(p.ws + WS_XSN) : nullptr;
          pg8::gemm_phase<EpiRes, pg8::StaticOrder, false>((PG8_LAS unsigned char*)shm, g, S, E, nullptr); }
        { const Params p = LP(); phase_pool(p, l, shm, 0, 0, (int)blockIdx.x, (int)gridDim.x, true, true); }
        { unsigned nxt = 0u;
          if (threadIdx.x == 0) { const Params p = LP(); nxt = __hip_atomic_fetch_add((unsigned*)(p.ws + WS_BAR) + 3584 + 64 * l, 1u, __ATOMIC_RELAXED, __HIP_MEMORY_SCOPE_AGENT); }
          for (;;) {
              if (threadIdx.x == 0) xst[2] = nxt;
              __syncthreads();
              const int item = (int)xst[2];
              __syncthreads();
              if (item >= 1280) break;
              if (threadIdx.x == 0) { const Params p = LP(); nxt = __hip_atomic_fetch_add((unsigned*)(p.ws + WS_BAR) + 3584 + 64 * l, 1u, __ATOMIC_RELAXED, __HIP_MEMORY_SCOPE_AGENT); }
              if (item < 256) { const Params p = LP(); phase_scan(p, l, item * NT, item * NT + NT, NT); }
              else if (item < 768) { const Params p = LP(); phase_pool(p, l, shm, item - 256, item - 255, 0, 1, false, false); }
              else { const Params p = LP(); phase_conv_prompt(p, l, (item - 768) * 1024, (item - 768) * 1024 + 1024, NT); }
          } }
        GSYNC();
        { const Params p = LP(); hgrn_pass<true>(p, l, shm); }
        GSYNC();
        if (l == 0) { const Params p = LP(); const u32x4* cs = (const u32x4*)(p.ws + WS_XSN); u32x4* cd = (u32x4*)(p.ws + WS_U + (size_t)MP * DM * 2);
          for (int i = blockIdx.x * NT + ltid(); i < 65536; i += gridDim.x * NT) cd[i] = cs[i]; }
        { const Params p = LP(); float* xs = p.out + O_Y; pg8::Gemm g; g.A = (const bf16_t*)(p.ws + WS_XB); g.Bt = (const bf16_t*)(p.ws + WS_WOUT) + (size_t)l * DM * DM; g.M = MP; g.N = DM; g.K = DM;
          pg8::StaticOrder S; S.init(MP, DM, (int)gridDim.x, (int)blockIdx.x); EpiRes E; E.X = xs; E.src = l == 0 ? p.x_prompt : xs; E.ssq = (float*)(p.ws + WS_SSQ) + (size_t)(l + 1) * MT; E.xbn = l == 0 ? (bf16_t*)(p.ws + WS_U) : nullptr;
          pg8::gemm_phase<EpiRes, pg8::StaticOrder, false>((PG8_LAS unsigned char*)shm, g, S, E, nullptr); }
        GSYNC();
        if (l == 1) { const Params p = LP(); phase_final(p); }
    }
}

extern "C" void kernel_launch(void* const* d_in, const int* in_sizes, int n_in, void* d_out, int out_size, void* d_ws, size_t ws_size, hipStream_t stream) {
    static int grid = 0;
    if (grid == 0) {
        if (n_in != 14 || out_size != (int)O_END || ws_size < WS_END) { fprintf(stderr, "kernel_launch: unexpected shapes: n_in %d out %d ws %zu\n", n_in, out_size, ws_size); grid = -1; return; }
        int dev = 0, cus = 0, per_cu = 0;
        (void)hipGetDevice(&dev); (void)hipDeviceGetAttribute(&cus, hipDeviceAttributeMultiprocessorCount, dev);
        if (hipFuncSetAttribute((const void*)hymba_fwd, hipFuncAttributeMaxDynamicSharedMemorySize, LDS_BYTES) != hipSuccess) { fprintf(stderr, "kernel_launch: hipFuncSetAttribute failed\n"); grid = -1; return; }
        if (hipOccupancyMaxActiveBlocksPerMultiprocessor(&per_cu, (const void*)hymba_fwd, NT, LDS_BYTES) != hipSuccess || per_cu < 1) { fprintf(stderr, "kernel_launch: occupancy query failed (%d)\n", per_cu); (void)hipGetLastError(); per_cu = 1; }
        if (cus < GRID) { fprintf(stderr, "kernel_launch: built for a %d-CU device, found %d CUs\n", GRID, cus); grid = -1; return; }
        grid = GRID;
    }
    if (grid < 0) return;
    Params p{};
    p.x_prompt = (const float*)d_in[0]; p.x_sample = (const float*)d_in[1]; p.state_conv = (const float*)d_in[2]; p.state_hgrn = (const float*)d_in[3]; p.state_pool = (const float*)d_in[4];
    p.norm_g = (const float*)d_in[5]; p.w_in = (const float*)d_in[6]; p.conv_w = (const float*)d_in[7]; p.hgrn_lb = (const float*)d_in[8]; p.hgrn_norm_g = (const float*)d_in[9];
    p.pool_w = (const float*)d_in[10]; p.pool_scale = (const float*)d_in[11]; p.w_out = (const float*)d_in[12]; p.final_norm_g = (const float*)d_in[13];
    p.out = (float*)d_out; p.ws = (unsigned char*)d_ws;
    if (hipMemsetAsync((char*)d_ws + WS_BAR, 0, 16384, stream) != hipSuccess) { fprintf(stderr, "kernel_launch: memset of barrier words failed\n"); return; }
    void* args[] = {&p};
    const hipError_t e = hipLaunchCooperativeKernel((const void*)hymba_fwd, dim3(grid), dim3(NT), args, LDS_BYTES, stream);
    if (e != hipSuccess) fprintf(stderr, "kernel_launch: cooperative launch failed: %s (grid %d)\n", hipGetErrorString(e), grid);
}
```

```cpp
#include <hip/hip_runtime.h>
#include <hip/hip_cooperative_groups.h>
#include <cstdio>
namespace cg = cooperative_groups;
namespace pg8 {
#define PG8_LAS __attribute__((address_space(3)))
typedef unsigned short bf16_t;
typedef short bf16x8 __attribute__((ext_vector_type(8)));
typedef float f32x4 __attribute__((ext_vector_type(4)));
typedef unsigned u32x4 __attribute__((ext_vector_type(4)));
constexpr int BM = 256, BK = 64, HALF = 128, HTB = HALF * BK * 2  , STAGE_BYTES = 8 * HTB, NXCD = 8, WGM = 8;

__host__ __device__ __forceinline__ int lds_byte(int r, int c) { const int st = (r >> 4) * 2 + (c >> 5), rr = r & 15, cc = c & 31, ob = rr * 64 + cc * 2; return st * 1024 + (ob ^ (((ob >> 9) & 1) << 5)); }
__host__ __device__ __forceinline__ void stage_rc(int b, int& R, int& C) { const int st = b / 1024, sb = b % 1024, swz = sb ^ (((sb >> 9) & 1) << 5); R = (st >> 1) * 16 + swz / 64; C = (st & 1) * 32 + (swz % 64) / 2; }
__host__ __device__ __forceinline__ int perm32(int rho) { const int n = rho >> 4, i = rho & 15; return 8 * (i >> 2) + 4 * n + (i & 3); }

struct Unit { int pm, pn; };
struct Gemm { const bf16_t* A; const bf16_t* Bt; int M, N, K; };

struct StaticOrder {
    int nM, nN, nwg, G, c;
    __host__ __device__ void init(int M, int N, int G_, int c_) { nM = M / BM; nN = N / BM; nwg = nM * nN; G = G_; c = c_; }
    __host__ __device__ bool next(int i, Unit& u) const {
        const long L = (long)i * G + c; if (L >= nwg) return false;
        int wgid = (int)L; { const int q = nwg / NXCD, r = nwg % NXCD, xcd = wgid % NXCD, off = wgid / NXCD; wgid = (xcd < r ? xcd * (q + 1) : r * (q + 1) + (xcd - r) * q) + off; }
        const int nig = WGM * nN, gid = wgid / nig, fm = gid * WGM, gsz = (nM - fm) < WGM ? (nM - fm) : WGM;
        u.pm = fm + ((wgid % nig) % gsz); u.pn = (wgid % nig) / gsz; return true;
    }
    __device__ __forceinline__ void a_ready(const Unit&) const {}
    __device__ __forceinline__ void done(const Unit&) const {}
};
__device__ __forceinline__ unsigned cvt_pk_bf16(float lo, float hi) { unsigned r; asm volatile("v_cvt_pk_bf16_f32 %0, %1, %2" : "=v"(r) : "v"(lo), "v"(hi)); return r; }
template <class Epi, class Sched, bool STAMP = false>
__device__ __forceinline__ void gemm_phase(PG8_LAS unsigned char* lds, const Gemm g, const Sched& S, const Epi& E, unsigned long long* stamps) {
    int tid_l = threadIdx.x; asm volatile("" : "+v"(tid_l));
    const int tid = tid_l, wid = __builtin_amdgcn_readfirstlane(tid >> 6), lane = tid & 63, wr = wid >> 2, wc = wid & 3, fr = lane & 15, fq = lane >> 4;
    const int K = g.K, nt = K / BK;
    int ts_lo = 0, ts_hi = 0, nts = 0; const unsigned long long rt_entry = STAMP ? (unsigned long long)wall_clock64() : 0ull;
#define PG8_STAMP() do { if (STAMP && wid == 0 && nts < 64) { const unsigned long long _c = (unsigned long long)clock64(); \
        ts_lo = (lane == nts) ? (int)(unsigned)_c : ts_lo; ts_hi = (lane == nts) ? (int)(unsigned)(_c >> 32) : ts_hi; ++nts; } } while (0)
    PG8_STAMP();
    unsigned voffA[2], voffB[2];
#pragma unroll
    for (int i = 0; i < 2; ++i) { int R, C; stage_rc(tid * 16 + i * 8192, R, C); const int Rb = Epi::PERM ? ((R & ~31) + perm32(R & 31)) : R;
        voffA[i] = (unsigned)(R * K + C) * 2u; voffB[i] = (unsigned)(Rb * K + C) * 2u; }
    const size_t kstep = (size_t)(BK * 2);
    const size_t hstep = (size_t)HALF * K * 2;
    const size_t tstep = 2 * hstep;
    const unsigned ldsw = (unsigned)wid * 1024u;
    const int aoff = lds_byte(wr * 64 + fr, fq * 8), boff = lds_byte(wc * 32 + fr, fq * 8);
#define PG8_SA(b, h) (((b) * 2 + (h)) * HTB)
#define PG8_SB(b, h) ((4 + (b) * 2 + (h)) * HTB)
#define PG8_STAGE(bufoff, gbase, voff) do { _Pragma("unroll") for (int _i = 0; _i < 2; ++_i) \
        __builtin_amdgcn_global_load_lds((const unsigned*)((const char*)(gbase) + (voff)[_i]), (PG8_LAS unsigned*)(lds + (bufoff) + ldsw + _i * 8192), 16, 0, 0); } while (0)
#define PG8_LDA(dst, b, h) do { _Pragma("unroll") for (int m = 0; m < 4; ++m) _Pragma("unroll") for (int k = 0; k < 2; ++k) dst[m][k] = *(const PG8_LAS bf16x8*)(lds + PG8_SA(b, h) + aoff + m * 2048 + k * 1024); } while (0)
#define PG8_LDB(dst, b, h) do { _Pragma("unroll") for (int n = 0; n < 2; ++n) _Pragma("unroll") for (int k = 0; k < 2; ++k) dst[n][k] = *(const PG8_LAS bf16x8*)(lds + PG8_SB(b, h) + boff + n * 2048 + k * 1024); } while (0)
#define PG8_MMA(ai, bj, At, Bt) do { __builtin_amdgcn_s_setprio(1); _Pragma("unroll") for (int m = 0; m < 4; ++m) _Pragma("unroll") for (int n = 0; n < 2; ++n) _Pragma("unroll") for (int k = 0; k < 2; ++k) \
        acc[ai][bj][m][n] = __builtin_amdgcn_mfma_f32_16x16x32_bf16(Bt[n][k], At[m][k], acc[ai][bj][m][n], 0, 0, 0); __builtin_amdgcn_s_setprio(0); } while (0)
#define PG8_WAIT_V(n) asm volatile("s_waitcnt vmcnt(" #n ")" ::: "memory")
#define PG8_WAIT_L(n) asm volatile("s_waitcnt lgkmcnt(" #n ")" ::: "memory")
#define PG8_BAR __builtin_amdgcn_s_barrier()
#define PG8_SCHED __builtin_amdgcn_sched_barrier(0)
    Unit cur, nxt; int ui = 0;
    if (!S.next(0, cur)) return;
    f32x4 acc[2][2][4][2];
#pragma unroll
    for (int a = 0; a < 2; ++a)
#pragma unroll
        for (int b = 0; b < 2; ++b)
#pragma unroll
            for (int m = 0; m < 4; ++m)
#pragma unroll
                for (int n = 0; n < 2; ++n) acc[a][b][m][n] = (f32x4){0.f, 0.f, 0.f, 0.f};
    bf16x8 At[4][2], B0[2][2], B1[2][2];
    const char* cA = (const char*)g.A + (size_t)cur.pm * tstep; const char* cB = (const char*)g.Bt + (size_t)cur.pn * tstep;
    S.a_ready(cur);
    PG8_STAGE(PG8_SB(0, 0), cB, voffB); PG8_STAGE(PG8_SA(0, 0), cA, voffA); PG8_STAGE(PG8_SB(0, 1), cB + hstep, voffB); PG8_STAGE(PG8_SA(0, 1), cA + hstep, voffA);
    if (wr == 1) PG8_BAR;
    PG8_WAIT_V(4); PG8_BAR;
    PG8_STAGE(PG8_SB(1, 0), cB + kstep, voffB); PG8_STAGE(PG8_SA(1, 0), cA + kstep, voffA); PG8_STAGE(PG8_SB(1, 1), cB + hstep + kstep, voffB);
    PG8_WAIT_V(6); PG8_BAR;
    PG8_STAMP();
    for (;;) {
        const bool has_next = S.next(ui + 1, nxt);
        const char* nA = has_next ? (const char*)g.A + (size_t)nxt.pm * tstep : cA; const char* nB = has_next ? (const char*)g.Bt + (size_t)nxt.pn * tstep : cB;
        for (int t = 0; t < nt; t += 2) {
            const bool last = (t == nt - 2);
            const char* a1 = cA + (size_t)(t + 1) * kstep;
            const char* a2 = last ? nA : cA + (size_t)(t + 2) * kstep; const char* b2 = last ? nB : cB + (size_t)(t + 2) * kstep;
            const char* a3 = a2 + kstep; const char* b3 = b2 + kstep;
            if (last && has_next) S.a_ready(nxt);
            if (last) E.prefetch(cur, wr, fr, lds, wid);
            PG8_LDB(B0, 0, 0); PG8_SCHED; PG8_LDA(At, 0, 0); PG8_STAGE(PG8_SA(1, 1), a1 + hstep, voffA);
            PG8_WAIT_L(8); PG8_BAR; PG8_WAIT_L(0); PG8_MMA(0, 0, At, B0); PG8_BAR; PG8_SCHED;
            PG8_LDB(B1, 0, 1); PG8_STAGE(PG8_SB(0, 0), b2, voffB);
            PG8_BAR; PG8_WAIT_L(0); PG8_MMA(0, 1, At, B1); PG8_BAR;
            PG8_LDA(At, 0, 1); PG8_STAGE(PG8_SA(0, 0), a2, voffA);
            PG8_BAR; PG8_WAIT_L(0); PG8_MMA(1, 0, At, B0); PG8_BAR; PG8_SCHED;
            PG8_STAGE(PG8_SB(0, 1), b2 + hstep, voffB);
            PG8_WAIT_V(6); PG8_BAR; PG8_MMA(1, 1, At, B1); PG8_BAR;
            PG8_LDB(B0, 1, 0); PG8_SCHED; PG8_LDA(At, 1, 0); PG8_STAGE(PG8_SA(0, 1), a2 + hstep, voffA);
            PG8_WAIT_L(8); PG8_BAR; PG8_WAIT_L(0); PG8_MMA(0, 0, At, B0); PG8_BAR; PG8_SCHED;
            PG8_LDB(B1, 1, 1); PG8_STAGE(PG8_SB(1, 0), b3, voffB);
            PG8_BAR; PG8_WAIT_L(0); PG8_MMA(0, 1, At, B1); PG8_BAR;
            PG8_LDA(At, 1, 1); PG8_STAGE(PG8_SA(1, 0), a3, voffA);
            PG8_BAR; PG8_WAIT_L(0); PG8_MMA(1, 0, At, B0); PG8_BAR; PG8_SCHED;
            PG8_STAGE(PG8_SB(1, 1), b3 + hstep, voffB);
            PG8_WAIT_V(6); PG8_BAR; PG8_MMA(1, 1, At, B1); PG8_BAR;
        }
        PG8_STAMP();
        if constexpr (!Epi::AFTER_DRAIN) { E(acc, cur, wr, wc, fr, fq, lds, wid, lane); S.done(cur); }
        PG8_STAMP();
        if (!has_next) break;
#pragma unroll
        for (int a = 0; a < 2; ++a)
#pragma unroll
            for (int b = 0; b < 2; ++b)
#pragma unroll
                for (int m = 0; m < 4; ++m)
#pragma unroll
                    for (int n = 0; n < 2; ++n) acc[a][b][m][n] = (f32x4){0.f, 0.f, 0.f, 0.f};
        cur = nxt; cA = nA; cB = nB; ++ui;
    }
    PG8_WAIT_V(0);
    if (wr == 0) PG8_BAR;
    PG8_BAR;
    if constexpr (Epi::AFTER_DRAIN) { E.fused(acc, cur, wr, wc, fr, fq, lds, wid, lane); S.done(cur); }
    PG8_STAMP();
    if (STAMP && wid == 0) { stamps[lane] = lane < nts ? (((unsigned long long)(unsigned)ts_hi << 32) | (unsigned)ts_lo) : 0ull;
        if (lane == 62) stamps[62] = rt_entry; if (lane == 63) stamps[63] = (unsigned long long)wall_clock64(); }
#undef PG8_STAMP
#undef PG8_SA
#undef PG8_SB
#undef PG8_STAGE
#undef PG8_LDA
#undef PG8_LDB
#undef PG8_MMA
#undef PG8_WAIT_V
#undef PG8_WAIT_L
#undef PG8_BAR
#undef PG8_SCHED
}
}
#define XB_TMO      128
#define XB_XCNT(j)  (256  + 64 * (j))
#define XB_XSUB(j)  (1280 + 64 * (j))
#define XB_XGEN(j)  (2304 + 64 * (j))
#define XB_TOP      3328
#define XB_TOPGEN   3392
#define XCD_BAR_WORDS 3456
#define XB_SPIN_CAP (1u << 18)
#define LAS __attribute__((address_space(3)))

__device__ __forceinline__ unsigned xb_ld(unsigned* p)              { return __hip_atomic_load(p, __ATOMIC_RELAXED, __HIP_MEMORY_SCOPE_AGENT); }
__device__ __forceinline__ unsigned xb_add(unsigned* p, unsigned v) { return __hip_atomic_fetch_add(p, v, __ATOMIC_RELAXED, __HIP_MEMORY_SCOPE_AGENT); }
__device__ __forceinline__ unsigned xb_xcc_id() { return (unsigned)__builtin_amdgcn_s_getreg((3 << 11) | 20) & 0xFu; }
#define XB_SPIN(cond, bar) do { unsigned _sp = 0; while (cond) { __builtin_amdgcn_s_sleep(1); \
    if ((++_sp & 255u) == 0u) { if (xb_ld(&(bar)[XB_TMO])) break; if (_sp > XB_SPIN_CAP) { atomicAdd(&(bar)[XB_TMO], 1u); break; } } } } while (0)

struct XcdBarrier {
    unsigned* bar; unsigned x;
    volatile LAS unsigned* st;
};

__device__ __forceinline__ XcdBarrier xcd_barrier_post(unsigned* bar, volatile LAS unsigned* st) {
    XcdBarrier b; b.bar = bar; b.x = xb_xcc_id(); b.st = st;
    if (threadIdx.x == 0) (void)xb_add(&bar[XB_XCNT(b.x)], 1u);
    return b;
}
__device__ __forceinline__ void xcd_barrier_complete(unsigned* bar, unsigned x, unsigned& nloc, unsigned& nx) {
    const unsigned G = gridDim.x * gridDim.y * gridDim.z;
    unsigned sum, cnt, mine, sp = 0u;
    for (;;) {
        sum = 0u; cnt = 0u; mine = 0u;
#pragma unroll
        for (unsigned j = 0; j < 16; ++j) { const unsigned c = xb_ld(&bar[XB_XCNT(j)]); sum += c; cnt += (c > 0u) ? 1u : 0u; mine = (j == x) ? c : mine; }
        if (sum == G) break;
        __builtin_amdgcn_s_sleep(1);
        if ((++sp & 255u) == 0u) { if (xb_ld(&bar[XB_TMO])) break; if (sp > XB_SPIN_CAP) { atomicAdd(&bar[XB_TMO], 1u); break; } }
    }
    nloc = mine > 0u ? mine : 1u; nx = cnt > 0u ? cnt : 1u;
}

__device__ __forceinline__ void xcd_barrier(const XcdBarrier& b) {
    asm volatile("s_waitcnt vmcnt(0)" ::: "memory");
    __syncthreads();
    if (threadIdx.x == 0) {
        unsigned* bar = b.bar;
        __builtin_amdgcn_s_waitcnt(0);
        unsigned nloc = b.st[0], nx = b.st[1];
        if (nloc == 0u) { xcd_barrier_complete(bar, b.x, nloc, nx); b.st[0] = nloc; b.st[1] = nx; }
        const unsigned old = xb_add(&bar[XB_XSUB(b.x)], 1u);
        const unsigned gen = old / nloc;
        if (old + 1u == (gen + 1u) * nloc) {
            __builtin_amdgcn_fence(__ATOMIC_RELEASE, "agent");
            asm volatile("s_waitcnt vmcnt(0)" ::: "memory");
            const unsigned og = xb_add(&bar[XB_TOP], 1u);
            const unsigned tg = og / nx;
            if (og + 1u == (tg + 1u) * nx) xb_add(&bar[XB_TOPGEN], 1u);
            else XB_SPIN(xb_ld(&bar[XB_TOPGEN]) == tg, bar);
            __builtin_amdgcn_fence(__ATOMIC_ACQUIRE, "agent");
            xb_add(&bar[XB_XGEN(b.x)], 1u);
            asm volatile("s_waitcnt vmcnt(0)" ::: "memory");
        } else {
            XB_SPIN(xb_ld(&bar[XB_XGEN(b.x)]) == gen, bar);
            __builtin_amdgcn_fence(__ATOMIC_ACQUIRE, "agent");
            asm volatile("s_waitcnt vmcnt(0)" ::: "memory");
        }
    }
    __syncthreads();
}


#define DI __device__ __forceinline__
typedef pg8::bf16_t bf16_t;
typedef short bf16x8 __attribute__((ext_vector_type(8)));
typedef float f32x4 __attribute__((ext_vector_type(4)));
typedef unsigned u32x4 __attribute__((ext_vector_type(4)));
typedef unsigned u32x2 __attribute__((ext_vector_type(2)));

constexpr int MP = 16384, MS = 512, MT = MP + MS, DM = 1024, DIN = 3584, NT = 512;
constexpr int C_AH = 0, C_AB = 256, C_AC = 512, C_AG = 768, C_Q = 1024, C_F = 1536, C_I = 2048, C_GB = 2560, C_PV = 3072, C_PG = 3328;
constexpr float EPS = 1e-6f;
constexpr size_t O_Y = 0, O_NCP = 17301504, O_NHP = 17309696, O_NPP = 18358272, O_NCS = 18419712, O_NHS = 18550784, O_NPS = 35328000, O_END = 36311040;
constexpr size_t WS_WIN = 0, WS_WOUT = 14680064, WS_RSTD = 18874368, WS_DEC = 18941952, WS_XB = 19466240, WS_Z = 54069248, WS_U = 175179776, WS_BAR = 242288640, WS_SSQ = 242288640 + 16384, WS_XSN = 242288640 + 16384 + 3 * 67584, WS_EBR = 242288640 + 16384 + 3 * 67584 + 1048576, WS_PWT = 242288640 + 16384 + 3 * 67584 + 1048576 + 524288, WS_END = 242288640 + 16384 + 3 * 67584 + 1048576 + 524288 + 2 * 36864;
#ifndef PASSC_PREFETCH
#define PASSC_PREFETCH 1
#endif
constexpr int GRID = 256;
constexpr int EPF_OFF = 131072 + 64;
constexpr int LDS_BYTES = 131072 + 64 + 16384;
constexpr int L_QM = 0, L_KM = 17408, L_VT = 34816, L_ST = 53248, L_AM = 88064, L_TOT = 97280, L_EB = 101376, L_SSQ = 101888;

struct Params {
    const float *x_prompt, *x_sample, *state_conv, *state_hgrn, *state_pool, *norm_g, *w_in, *conv_w, *hgrn_lb, *hgrn_norm_g, *pool_w, *pool_scale, *w_out, *final_norm_g;
    float* out; unsigned char* ws;
};

DI float bf2f(bf16_t b) { return __uint_as_float(((unsigned)b) << 16); }
typedef __bf16 hbf2 __attribute__((ext_vector_type(2)));
typedef float hf2 __attribute__((ext_vector_type(2)));
DI unsigned pk2(float lo, float hi) { const hf2 v = {lo, hi}; return __builtin_bit_cast(unsigned, __builtin_convertvector(v, hbf2)); }
DI bf16_t f2bf(float f) { return (bf16_t)(pk2(f, f) & 0xffffu); }
DI float frcp(float x) { return __builtin_amdgcn_rcpf(x); }
DI void unpack8(u32x4 w, float (&o)[8]) {
    o[0] = __uint_as_float(w.x << 16); o[1] = __uint_as_float(w.x & 0xffff0000u); o[2] = __uint_as_float(w.y << 16); o[3] = __uint_as_float(w.y & 0xffff0000u);
    o[4] = __uint_as_float(w.z << 16); o[5] = __uint_as_float(w.z & 0xffff0000u); o[6] = __uint_as_float(w.w << 16); o[7] = __uint_as_float(w.w & 0xffff0000u);
}
DI int ltid() { int t = threadIdx.x; asm volatile("" : "+v"(t)); return t; }
DI float4 ldnt4(const float* p) { const f32x4 v = __builtin_nontemporal_load((const f32x4*)p); return make_float4(v[0], v[1], v[2], v[3]); }
DI void stnt4(float* p, float4 v) { const f32x4 w = {v.x, v.y, v.z, v.w}; __builtin_nontemporal_store(w, (f32x4*)p); }
DI float silu(float x) { return x * frcp(1.0f + __expf(-x)); }
DI float wave_sum(float v) {
#pragma unroll
    for (int o = 32; o >= 1; o >>= 1) v += __shfl_xor(v, o, 64);
    return v;
}

struct EpiZ {
    static constexpr bool PERM = true, AFTER_DRAIN = false;
    bf16_t* O; const float* ssq;
    DI void prefetch(const pg8::Unit& u, int wr, int fr, PG8_LAS unsigned char* lds, int wid) const {
        if (ssq) { const float* g = ssq + u.pm * 256 + wr * 64 + fr;
#pragma unroll
            for (int i = 0; i < 8; ++i) __builtin_amdgcn_global_load_lds((const unsigned*)(g + (i >> 2) * 128 + (i & 3) * 16), (PG8_LAS unsigned*)(lds + EPF_OFF + wid * 2048 + i * 256), 4, 0, 0); }
    }
    DI void operator()(const f32x4 (&acc)[2][2][4][2], const pg8::Unit& u, int wr, int wc, int fr, int fq, PG8_LAS unsigned char* lds, int wid, int lane) const {
        const int row0 = u.pm * 256 + wr * 64 + fr, col0 = u.pn * 256 + wc * 32 + 8 * fq;
#pragma unroll
        for (int ai = 0; ai < 2; ++ai)
#pragma unroll
            for (int m = 0; m < 4; ++m) {
                const int r = row0 + ai * 128 + m * 16; const float s = ssq ? rsqrtf(*(const PG8_LAS float*)(lds + EPF_OFF + wid * 2048 + (ai * 4 + m) * 256 + lane * 4) * (1.0f / DM) + EPS) : 1.0f; bf16_t* rowp = O + (size_t)r * DIN + col0;
#pragma unroll
                for (int bj = 0; bj < 2; ++bj) { const f32x4 v0 = acc[ai][bj][m][0] * s, v1 = acc[ai][bj][m][1] * s;
                    u32x4 w; w.x = pg8::cvt_pk_bf16(v0[0], v0[1]); w.y = pg8::cvt_pk_bf16(v0[2], v0[3]); w.z = pg8::cvt_pk_bf16(v1[0], v1[1]); w.w = pg8::cvt_pk_bf16(v1[2], v1[3]);
                    *(u32x4*)(rowp + bj * 128) = w; } }
    }
};
struct EpiRes {
    static constexpr bool PERM = false, AFTER_DRAIN = true;
    float* X; const float* src; float* ssq; bf16_t* xbn;
    DI void prefetch(const pg8::Unit&, int, int, PG8_LAS unsigned char*, int) const {}
    DI void operator()(const f32x4 (&)[2][2][4][2], const pg8::Unit&, int, int, int, int, PG8_LAS unsigned char*, int, int) const {}
    DI void fused(const f32x4 (&acc)[2][2][4][2], const pg8::Unit& u, int wr, int wc, int fr, int fq, PG8_LAS unsigned char* lds, int wid, int lane) const {
        typedef PG8_LAS f32x4* LP4;
#pragma unroll
        for (int ai = 0; ai < 2; ++ai) {
#pragma unroll
            for (int m = 0; m < 4; ++m) { const int rl = wr * 64 + m * 16 + fr;
#pragma unroll
                for (int bj = 0; bj < 2; ++bj)
#pragma unroll
                    for (int n = 0; n < 2; ++n) { const int c4 = bj * 32 + wc * 8 + n * 4 + fq; *(LP4)(lds + rl * 1024 + ((c4 ^ (rl & 15)) << 4)) = acc[ai][bj][m][n]; } }
            __syncthreads();
#pragma unroll
            for (int half = 0; half < 2; ++half) {
                f32x4 sv[8];
#pragma unroll
                for (int rr = 0; rr < 8; ++rr) { const int row = wid * 16 + half * 8 + rr; const size_t go = (size_t)(u.pm * 256 + ai * 128 + row) * DM + u.pn * 256 + lane * 4; sv[rr] = __builtin_nontemporal_load((const f32x4*)(src + go)); }
                float part[8];
#pragma unroll
                for (int rr = 0; rr < 8; ++rr) { const int row = wid * 16 + half * 8 + rr; const int gr = u.pm * 256 + ai * 128 + row; const size_t go = (size_t)gr * DM + u.pn * 256 + lane * 4;
                    const f32x4 o = sv[rr] + *(LP4)(lds + row * 1024 + ((lane ^ (row & 15)) << 4));
                    *(f32x4*)(X + go) = o;
                    if (xbn) { u32x2 w; w.x = pk2(o[0], o[1]); w.y = pk2(o[2], o[3]); *(u32x2*)(xbn + go) = w; }
                    part[rr] = o[0] * o[0] + o[1] * o[1] + o[2] * o[2] + o[3] * o[3]; }
                { const bool h1 = (lane & 32) != 0, h2 = (lane & 16) != 0, h3 = (lane & 8) != 0; float q4[4], q2[2];
#pragma unroll
                  for (int i = 0; i < 4; ++i) { const float snd = h1 ? part[i] : part[i + 4], kp = h1 ? part[i + 4] : part[i]; q4[i] = kp + __shfl_xor(snd, 32, 64); }
#pragma unroll
                  for (int i = 0; i < 2; ++i) { const float snd = h2 ? q4[i] : q4[i + 2], kp = h2 ? q4[i + 2] : q4[i]; q2[i] = kp + __shfl_xor(snd, 16, 64); }
                  float q1; { const float snd = h3 ? q2[0] : q2[1], kp = h3 ? q2[1] : q2[0]; q1 = kp + __shfl_xor(snd, 8, 64); }
                  q1 += __shfl_xor(q1, 4, 64); q1 += __shfl_xor(q1, 2, 64); q1 += __shfl_xor(q1, 1, 64);
                  const int rsel = (h3 ? 1 : 0) + (h2 ? 2 : 0) + (h1 ? 4 : 0);
                  if ((lane & 7) == 0) (void)__hip_atomic_fetch_add(ssq + u.pm * 256 + ai * 128 + wid * 16 + half * 8 + rsel, q1, __ATOMIC_RELAXED, __HIP_MEMORY_SCOPE_AGENT); }
            }
            __syncthreads();
        }
    }
};

struct WTile { const float* src; bf16_t* dst; const float* g; int N, kt, nt; };
DI WTile wtile_of(const Params& p, int ti) {
    constexpr int T_IN = 2 * 16 * 56; WTile w;
    bf16_t* win = (bf16_t*)(p.ws + WS_WIN); bf16_t* wout = (bf16_t*)(p.ws + WS_WOUT);
    if (ti < T_IN) { const int l = ti / (16 * 56), r = ti % (16 * 56); w.kt = r / 56; w.nt = r % 56; w.N = DIN; w.src = p.w_in + (size_t)l * DM * DIN; w.dst = win + (size_t)l * DIN * DM; w.g = p.norm_g + l * DM; }
    else { const int tt = ti - T_IN; const int l = tt / 256, r = tt % 256; w.kt = r / 16; w.nt = r % 16; w.N = DM; w.src = p.w_out + (size_t)l * DM * DM; w.dst = wout + (size_t)l * DM * DM; w.g = nullptr; }
    return w;
}
DI void wtile_ld(const WTile& w, int tid, float4 (&v)[2], float (&gg)[2]) {
#pragma unroll
    for (int i = 0; i < 2; ++i) { const int k = (tid >> 4) + 32 * i, n4 = (tid & 15) * 4;
        v[i] = ldnt4(w.src + (size_t)(w.kt * 64 + k) * w.N + w.nt * 64 + n4); gg[i] = w.g ? w.g[w.kt * 64 + k] : 1.0f; }
}
DI void phase_weights(const Params& p, unsigned char* lds, int ti_lo, int T_ALL, int blk, int nblk) {
    const int tid = ltid(); float* t = (float*)lds;
    float4 v[2]; float gg[2];
    int ti = ti_lo + blk;
    if (ti < T_ALL) { const WTile w = wtile_of(p, ti); wtile_ld(w, tid, v, gg); }
    for (; ti < T_ALL; ti += nblk) {
        const WTile w = wtile_of(p, ti);
#pragma unroll
        for (int i = 0; i < 2; ++i) { const int k = (tid >> 4) + 32 * i, n4 = (tid & 15) * 4;
            t[k * 65 + n4 + 0] = v[i].x * gg[i]; t[k * 65 + n4 + 1] = v[i].y * gg[i]; t[k * 65 + n4 + 2] = v[i].z * gg[i]; t[k * 65 + n4 + 3] = v[i].w * gg[i]; }
        if (ti + nblk < T_ALL) { const WTile wn = wtile_of(p, ti + nblk); wtile_ld(wn, tid, v, gg); }
        __syncthreads();
        { const int n = tid >> 3, k8 = (tid & 7) * 8; u32x4 o;
          o.x = pk2(t[(k8 + 0) * 65 + n], t[(k8 + 1) * 65 + n]); o.y = pk2(t[(k8 + 2) * 65 + n], t[(k8 + 3) * 65 + n]);
          o.z = pk2(t[(k8 + 4) * 65 + n], t[(k8 + 5) * 65 + n]); o.w = pk2(t[(k8 + 6) * 65 + n], t[(k8 + 7) * 65 + n]);
          *(u32x4*)(w.dst + (size_t)(w.nt * 64 + n) * DM + w.kt * 64 + k8) = o; }
        __syncthreads();
    }
}

DI void phase_norm0(const Params& p) {
    const int tid_ = ltid(), wid = tid_ >> 6, lane = tid_ & 63;
    bf16_t* xb = (bf16_t*)(p.ws + WS_XB); float* ssq = (float*)(p.ws + WS_SSQ);
    for (int i = blockIdx.x * NT + tid_; i < 2 * MT; i += gridDim.x * NT) ssq[MT + i] = 0.f;
    for (int i = blockIdx.x * NT + tid_; i < 2 * 16384; i += gridDim.x * NT) { const int l = i >> 14, r = i & 16383, g = r >> 12, c = (r >> 6) & 63, d = r & 63;
        *(bf16_t*)(p.ws + WS_PWT + (size_t)l * 36864 + (g * 64 + d) * 144 + c * 2) = f2bf(p.pool_w[i]); }
    const int rstride = gridDim.x * 8;
    for (int row = blockIdx.x * 8 + wid; row < MT; row += 2 * rstride) {
        const int row2 = row + rstride; const bool two = row2 < MT; const int rb = two ? row2 : row;
        const float* sa = row < MP ? p.x_prompt + (size_t)row * DM : p.x_sample + (size_t)(row - MP) * DM;
        const float* sb = rb < MP ? p.x_prompt + (size_t)rb * DM : p.x_sample + (size_t)(rb - MP) * DM;
        float4 va[4], vb[4]; float ssa = 0.f, ssb = 0.f;
#pragma unroll
        for (int i = 0; i < 4; ++i) { va[i] = ldnt4(sa + i * 256 + lane * 4); vb[i] = ldnt4(sb + i * 256 + lane * 4); }
#pragma unroll
        for (int i = 0; i < 4; ++i) { ssa += va[i].x * va[i].x + va[i].y * va[i].y + va[i].z * va[i].z + va[i].w * va[i].w; ssb += vb[i].x * vb[i].x + vb[i].y * vb[i].y + vb[i].z * vb[i].z + vb[i].w * vb[i].w; }
        ssa = wave_sum(ssa); ssb = wave_sum(ssb);
        const float ra = rsqrtf(ssa * (1.0f / DM) + EPS), rb2 = rsqrtf(ssb * (1.0f / DM) + EPS);
#pragma unroll
        for (int i = 0; i < 4; ++i) { u32x2 w; w.x = pk2(va[i].x * ra, va[i].y * ra); w.y = pk2(va[i].z * ra, va[i].w * ra); *(u32x2*)(xb + (size_t)row * DM + i * 256 + lane * 4) = w;
            if (two) { u32x2 w2; w2.x = pk2(vb[i].x * rb2, vb[i].y * rb2); w2.y = pk2(vb[i].z * rb2, vb[i].w * rb2); *(u32x2*)(xb + (size_t)row2 * DM + i * 256 + lane * 4) = w2; } }
    }
}
DI void phase_final(const Params& p) {
    float* xs = p.out + O_Y; const float* ssq = (const float*)(p.ws + WS_SSQ) + 2 * MT;
    const int stride = gridDim.x * NT;
    for (int i0 = blockIdx.x * NT + ltid(); i0 < MT * 256; i0 += 8 * stride) {
        float4 v[8]; float r[8];
#pragma unroll
        for (int k = 0; k < 8; ++k) { const int idx = i0 + k * stride; if (idx < MT * 256) { v[k] = ldnt4(xs + (size_t)idx * 4); r[k] = ssq[idx >> 8]; } }
#pragma unroll
        for (int k = 0; k < 8; ++k) { const int idx = i0 + k * stride; if (idx < MT * 256) { const float rr = rsqrtf(r[k] * (1.0f / DM) + EPS);
            const float4 g = *(const float4*)(p.final_norm_g + (idx & 255) * 4); float4 o = v[k];
            o.x *= rr * g.x; o.y *= rr * g.y; o.z *= rr * g.z; o.w *= rr * g.w; stnt4(xs + (size_t)idx * 4, o); } }
    }
}

DI void phase_conv(const Params& p, int l, int row_lo, int row_hi, int blk, int nblk) {
    const bf16_t* z = (const bf16_t*)(p.ws + WS_Z); bf16_t* mix = (bf16_t*)(p.ws + WS_XB);
    const float* cw = p.conv_w + l * 3 * 256;
    for (int idx = row_lo * 32 + blk * NT + ltid(); idx < row_hi * 32; idx += nblk * NT) {
        const int row = idx >> 5, c = (idx & 31) * 8;
        int t, T; const float* buf; float* nc;
        if (row < MP) { const int b = row >> 11; t = row & 2047; T = 2048; buf = nullptr; nc = p.out + O_NCP + (size_t)(l * 8 + b) * 512; }
        else { const int rr = row - MP; const int b = rr >> 2; t = rr & 3; T = 4; buf = p.state_conv + (size_t)(l * 128 + b) * 512; nc = p.out + O_NCS + (size_t)(l * 128 + b) * 512; }
        float u[3][8];
#pragma unroll
        for (int j = 0; j < 3; ++j) {
            const int tp = t - 2 + j;
            if (tp >= 0) { const bf16_t* zr = z + (size_t)(row - 2 + j) * DIN + c; float ah[8], ac[8]; unpack8(*(const u32x4*)(zr + C_AH), ah); unpack8(*(const u32x4*)(zr + C_AC), ac);
#pragma unroll
                for (int i = 0; i < 8; ++i) u[j][i] = ah[i] * ac[i]; }
            else if (buf) { const float4 a = *(const float4*)(buf + (tp + 2) * 256 + c), b4 = *(const float4*)(buf + (tp + 2) * 256 + c + 4);
                u[j][0] = a.x; u[j][1] = a.y; u[j][2] = a.z; u[j][3] = a.w; u[j][4] = b4.x; u[j][5] = b4.y; u[j][6] = b4.z; u[j][7] = b4.w; }
            else {
#pragma unroll
                for (int i = 0; i < 8; ++i) u[j][i] = 0.f; }
        }
        const bf16_t* zr = z + (size_t)row * DIN + c; float ab[8], ag[8]; unpack8(*(const u32x4*)(zr + C_AB), ab); unpack8(*(const u32x4*)(zr + C_AG), ag);
        float w0[8], w1[8], w2[8];
        { const float4 a0 = *(const float4*)(cw + c), a1 = *(const float4*)(cw + c + 4), b0 = *(const float4*)(cw + 256 + c), b1 = *(const float4*)(cw + 256 + c + 4), c0 = *(const float4*)(cw + 512 + c), c1 = *(const float4*)(cw + 512 + c + 4);
          w0[0] = a0.x; w0[1] = a0.y; w0[2] = a0.z; w0[3] = a0.w; w0[4] = a1.x; w0[5] = a1.y; w0[6] = a1.z; w0[7] = a1.w;
          w1[0] = b0.x; w1[1] = b0.y; w1[2] = b0.z; w1[3] = b0.w; w1[4] = b1.x; w1[5] = b1.y; w1[6] = b1.z; w1[7] = b1.w;
          w2[0] = c0.x; w2[1] = c0.y; w2[2] = c0.z; w2[3] = c0.w; w2[4] = c1.x; w2[5] = c1.y; w2[6] = c1.z; w2[7] = c1.w; }
        float o[8];
#pragma unroll
        for (int i = 0; i < 8; ++i) { const float y = w0[i] * u[0][i] + w1[i] * u[1][i] + w2[i] * u[2][i]; o[i] = ab[i] * y * silu(ag[i]); }
        u32x4 w; w.x = pk2(o[0], o[1]); w.y = pk2(o[2], o[3]); w.z = pk2(o[4], o[5]); w.w = pk2(o[6], o[7]);
        *(u32x4*)(mix + (size_t)row * DM + c) = w;
        if (t >= T - 2) { float* d = nc + (t - (T - 2)) * 256 + c; *(float4*)d = make_float4(u[2][0], u[2][1], u[2][2], u[2][3]); *(float4*)(d + 4) = make_float4(u[2][4], u[2][5], u[2][6], u[2][7]); }
    }
}

DI void conv_ld(const bf16_t* z, int idx, u32x4 (&r)[8]) {
    const int row = idx >> 5, c = (idx & 31) * 8, t = row & 2047; const bf16_t* zr = z + (size_t)row * DIN + c;
#pragma unroll
    for (int j = 0; j < 3; ++j) { const bf16_t* q = zr - (size_t)((t - 2 + j >= 0) ? (2 - j) * DIN : 0); r[2 * j] = *(const u32x4*)(q + C_AH); r[2 * j + 1] = *(const u32x4*)(q + C_AC); }
    r[6] = *(const u32x4*)(zr + C_AB); r[7] = *(const u32x4*)(zr + C_AG);
}
DI void conv_fin(const Params& p, int l, int idx, const u32x4 (&r)[8]) {
    const int row = idx >> 5, c = (idx & 31) * 8, t = row & 2047; const float* cw = p.conv_w + l * 3 * 256;
    float u[3][8];
#pragma unroll
    for (int j = 0; j < 3; ++j) { float ah[8], ac[8]; unpack8(r[2 * j], ah); unpack8(r[2 * j + 1], ac); const float m = (t - 2 + j >= 0) ? 1.f : 0.f;
#pragma unroll
        for (int i = 0; i < 8; ++i) u[j][i] = ah[i] * ac[i] * m; }
    float ab[8], ag[8]; unpack8(r[6], ab); unpack8(r[7], ag);
    float w0[8], w1[8], w2[8];
    { const float4 a0 = *(const float4*)(cw + c), a1 = *(const float4*)(cw + c + 4), b0 = *(const float4*)(cw + 256 + c), b1 = *(const float4*)(cw + 256 + c + 4), c0 = *(const float4*)(cw + 512 + c), c1 = *(const float4*)(cw + 512 + c + 4);
      w0[0] = a0.x; w0[1] = a0.y; w0[2] = a0.z; w0[3] = a0.w; w0[4] = a1.x; w0[5] = a1.y; w0[6] = a1.z; w0[7] = a1.w;
      w1[0] = b0.x; w1[1] = b0.y; w1[2] = b0.z; w1[3] = b0.w; w1[4] = b1.x; w1[5] = b1.y; w1[6] = b1.z; w1[7] = b1.w;
      w2[0] = c0.x; w2[1] = c0.y; w2[2] = c0.z; w2[3] = c0.w; w2[4] = c1.x; w2[5] = c1.y; w2[6] = c1.z; w2[7] = c1.w; }
    float o[8];
#pragma unroll
    for (int i = 0; i < 8; ++i) { const float y = w0[i] * u[0][i] + w1[i] * u[1][i] + w2[i] * u[2][i]; o[i] = ab[i] * y * silu(ag[i]); }
    u32x4 w; w.x = pk2(o[0], o[1]); w.y = pk2(o[2], o[3]); w.z = pk2(o[4], o[5]); w.w = pk2(o[6], o[7]);
    *(u32x4*)((bf16_t*)(p.ws + WS_XB) + (size_t)row * DM + c) = w;
    if (t >= 2046) { float* d = p.out + O_NCP + (size_t)(l * 8 + (row >> 11)) * 512 + (t - 2046) * 256 + c; *(float4*)d = make_float4(u[2][0], u[2][1], u[2][2], u[2][3]); *(float4*)(d + 4) = make_float4(u[2][4], u[2][5], u[2][6], u[2][7]); }
}
DI void phase_conv_prompt(const Params& p, int l, int idx_lo, int idx_hi, int stride) {
    const bf16_t* z = (const bf16_t*)(p.ws + WS_Z);
    for (int idx = idx_lo + ltid(); idx < idx_hi; idx += 2 * stride) {
        u32x4 ra[8], rb[8]; const bool two = idx + stride < idx_hi;
        conv_ld(z, idx, ra); conv_ld(z, two ? idx + stride : idx, rb);
        conv_fin(p, l, idx, ra); if (two) conv_fin(p, l, idx + stride, rb);
    }
}

DI void pool_ld(const bf16_t* z, int tile, int tid, u32x4 (&vld)[3], u32x4 (&gld)[2]) {
    const int row0 = tile * 32, t0 = row0 & 2047;
#pragma unroll
    for (int k = 0; k < 3; ++k) { const int it = tid + k * NT, rr = it >> 5, c = (it & 31) * 8; vld[k] = (u32x4){0u, 0u, 0u, 0u};
        if (it < 47 * 32 && t0 - 15 + rr >= 0) vld[k] = *(const u32x4*)(z + (size_t)(row0 - 15 + rr) * DIN + C_PV + c); }
#pragma unroll
    for (int k = 0; k < 2; ++k) { const int it = tid + k * NT, tl = it >> 5, c = (it & 31) * 8; gld[k] = *(const u32x4*)(z + (size_t)(row0 + tl) * DIN + C_PG + c); }
}
DI void phase_pool(const Params& p, int l, unsigned char* lds, int tile_lo, int tile_hi, int blk, int nblk, bool do_bufs, bool setup = true) {
    const int tid = ltid(), wid = tid >> 6, lane = tid & 63, lr = lane & 15, lq = lane >> 4;
    const bf16_t* z = (const bf16_t*)(p.ws + WS_Z); bf16_t* mix = (bf16_t*)(p.ws + WS_XB);
    constexpr int P_PWT = 0, P_UB = 36864, P_GT = 53760, P_OB = 87040, P_VT = 103936;
    float* gt = (float*)(lds + P_GT);
    __syncthreads();
    if (setup) { const u32x4* img = (const u32x4*)(p.ws + WS_PWT + (size_t)l * 36864);
      for (int i = tid; i < 2304; i += NT) *(u32x4*)(lds + P_PWT + i * 16) = img[i]; }
    u32x4 vld[3], gld[2];
    if (tile_lo + blk < tile_hi && tile_lo + blk < 512) pool_ld(z, tile_lo + blk, tid, vld, gld);
    for (int tile = tile_lo + blk; tile < tile_hi; tile += nblk) {
        __syncthreads();
        if (tile < 512) {
            const int row0 = tile * 32, t0 = row0 & 2047;
#pragma unroll
            for (int k = 0; k < 3; ++k) { const int it = tid + k * NT, rr = it >> 5, c = (it & 31) * 8; if (it < 47 * 32) *(u32x4*)(lds + P_VT + rr * 528 + c * 2) = vld[k]; }
#pragma unroll
            for (int k = 0; k < 2; ++k) { const int it = tid + k * NT, tl = it >> 5, c = (it & 31) * 8;
                float g[8]; unpack8(gld[k], g);
                const float4 s0 = *(const float4*)(p.pool_scale + l * 256 + c), s1 = *(const float4*)(p.pool_scale + l * 256 + c + 4);
                *(float4*)(gt + tl * 260 + c) = make_float4(s0.x * silu(g[0]), s0.y * silu(g[1]), s0.z * silu(g[2]), s0.w * silu(g[3]));
                *(float4*)(gt + tl * 260 + c + 4) = make_float4(s1.x * silu(g[4]), s1.y * silu(g[5]), s1.z * silu(g[6]), s1.w * silu(g[7])); }
            if (tile + nblk < tile_hi && tile + nblk < 512) pool_ld(z, tile + nblk, tid, vld, gld);
            __syncthreads();
#pragma unroll
            for (int k = 0; k < 2; ++k) { const int it = tid + k * NT, tl = it >> 5, c = (it & 31) * 8, gi = c >> 6, w = 2 << gi;
                float s[8], cur[8];
                unpack8(*(const u32x4*)(lds + P_VT + (tl + 15) * 528 + c * 2), cur);
#pragma unroll
                for (int i = 0; i < 8; ++i) s[i] = cur[i];
                for (int j = 1; j < w; ++j) { float v[8]; unpack8(*(const u32x4*)(lds + P_VT + (tl + 15 - j) * 528 + c * 2), v);
#pragma unroll
                    for (int i = 0; i < 8; ++i) s[i] += v[i]; }
                const float inv = frcp((float)min(w, t0 + tl + 1));
                u32x4 uw; uw.x = pk2(s[0] * inv - cur[0], s[1] * inv - cur[1]); uw.y = pk2(s[2] * inv - cur[2], s[3] * inv - cur[3]);
                uw.z = pk2(s[4] * inv - cur[4], s[5] * inv - cur[5]); uw.w = pk2(s[6] * inv - cur[6], s[7] * inv - cur[7]);
                *(u32x4*)(lds + P_UB + tl * 528 + c * 2) = uw; }
        } else {
            for (int it = tid; it < 1024; it += NT) {
                const int tl = it >> 5, c = (it & 31) * 8, gi = c >> 6, w = 2 << gi;
                const int row = MP + (tile - 512) * 32 + tl, rr = row - MP, t = rr & 3; const float* buf = p.state_pool + (size_t)(l * 128 + (rr >> 2)) * 15 * 256;
                float s[8], cur[8];
                unpack8(*(const u32x4*)(z + (size_t)row * DIN + C_PV + c), cur);
#pragma unroll
                for (int i = 0; i < 8; ++i) s[i] = cur[i];
#pragma unroll
                for (int j = 1; j < 4; ++j) { float v[8]; unpack8(*(const u32x4*)(z + (size_t)(row - min(j, t)) * DIN + C_PV + c), v); const float m = (j <= t && j < w) ? 1.f : 0.f;
#pragma unroll
                    for (int i = 0; i < 8; ++i) s[i] += m * v[i]; }
#pragma unroll
                for (int j = 1; j < 16; ++j) { const int tp = t - j, bi = tp < 0 ? 15 + tp : 0; const float m = (tp < 0 && j < w) ? 1.f : 0.f;
                    const float4 a = *(const float4*)(buf + bi * 256 + c), b4 = *(const float4*)(buf + bi * 256 + c + 4);
                    s[0] += m * a.x; s[1] += m * a.y; s[2] += m * a.z; s[3] += m * a.w; s[4] += m * b4.x; s[5] += m * b4.y; s[6] += m * b4.z; s[7] += m * b4.w; }
                const float inv = frcp((float)w);
                u32x4 uw; uw.x = pk2(s[0] * inv - cur[0], s[1] * inv - cur[1]); uw.y = pk2(s[2] * inv - cur[2], s[3] * inv - cur[3]);
                uw.z = pk2(s[4] * inv - cur[4], s[5] * inv - cur[5]); uw.w = pk2(s[6] * inv - cur[6], s[7] * inv - cur[7]);
                *(u32x4*)(lds + P_UB + tl * 528 + c * 2) = uw;
                float g[8]; unpack8(*(const u32x4*)(z + (size_t)row * DIN + C_PG + c), g);
                const float4 s0 = *(const float4*)(p.pool_scale + l * 256 + c), s1 = *(const float4*)(p.pool_scale + l * 256 + c + 4);
                *(float4*)(gt + tl * 260 + c) = make_float4(s0.x * silu(g[0]), s0.y * silu(g[1]), s0.z * silu(g[2]), s0.w * silu(g[3]));
                *(float4*)(gt + tl * 260 + c + 4) = make_float4(s1.x * silu(g[4]), s1.y * silu(g[5]), s1.z * silu(g[6]), s1.w * silu(g[7]));
            }
        }
        __syncthreads();
        { const int gi = wid >> 1, tt = wid & 1;
          f32x4 acc[4];
#pragma unroll
          for (int n = 0; n < 4; ++n) acc[n] = (f32x4){0.f, 0.f, 0.f, 0.f};
#pragma unroll
          for (int ks = 0; ks < 2; ++ks) { const bf16x8 a = *(const bf16x8*)(lds + P_UB + (tt * 16 + lr) * 528 + (gi * 64 + ks * 32 + lq * 8) * 2);
#pragma unroll
              for (int n = 0; n < 4; ++n) { const bf16x8 bb = *(const bf16x8*)(lds + P_PWT + (gi * 64 + n * 16 + lr) * 144 + (ks * 32 + lq * 8) * 2);
                  acc[n] = __builtin_amdgcn_mfma_f32_16x16x32_bf16(a, bb, acc[n], 0, 0, 0); } }
#pragma unroll
          for (int n = 0; n < 4; ++n)
#pragma unroll
              for (int j = 0; j < 4; ++j) { const int t = tt * 16 + lq * 4 + j, ch = gi * 64 + n * 16 + lr;
                  *(bf16_t*)(lds + P_OB + t * 528 + ch * 2) = f2bf(acc[n][j] * gt[t * 260 + ch]); } }
        __syncthreads();
        for (int it = tid; it < 1024; it += NT) { const int tl = it >> 5, c = (it & 31) * 8;
            const int row = tile < 512 ? tile * 32 + tl : MP + (tile - 512) * 32 + tl;
            *(u32x4*)(mix + (size_t)row * DM + 768 + c) = *(const u32x4*)(lds + P_OB + tl * 528 + c * 2); }
    }
    if (do_bufs)
    for (int idx = blk * NT + tid; idx < 136 * 15 * 32; idx += nblk * NT) {
        const int c = (idx & 31) * 8, r = idx >> 5, j = r % 15, bg = r / 15;
        float v[8]; float* dst;
        if (bg < 8) { unpack8(*(const u32x4*)(z + (size_t)(bg * 2048 + 2048 - 15 + j) * DIN + C_PV + c), v); dst = p.out + O_NPP + (size_t)((l * 8 + bg) * 15 + j) * 256 + c; }
        else { const int b = bg - 8, tp = j - 11; dst = p.out + O_NPS + (size_t)((l * 128 + b) * 15 + j) * 256 + c;
            if (tp < 0) { const float* sp = p.state_pool + (size_t)((l * 128 + b) * 15 + j + 4) * 256 + c; const float4 a = *(const float4*)sp, b4 = *(const float4*)(sp + 4);
                v[0] = a.x; v[1] = a.y; v[2] = a.z; v[3] = a.w; v[4] = b4.x; v[5] = b4.y; v[6] = b4.z; v[7] = b4.w; }
            else unpack8(*(const u32x4*)(z + (size_t)(MP + b * 4 + tp) * DIN + C_PV + c), v); }
        *(float4*)dst = make_float4(v[0], v[1], v[2], v[3]); *(float4*)(dst + 4) = make_float4(v[4], v[5], v[6], v[7]);
    }
    __syncthreads();
}

DI float lb_of(const Params& p, int l, int d) {
    if (l == 0) return 0.f;
    const float a0 = p.hgrn_lb[d], a1 = p.hgrn_lb[512 + d];
    return frcp(1.0f + __expf(a0 - a1));
}
DI void gate_fk(float x, float lb, float& f, float& k) {
    x = fminf(fmaxf(x, -30.f), 30.f);
    const float e = __expf(-x), sig = frcp(1.0f + e);
    f = lb + (1.0f - lb) * sig; k = (1.0f - lb) * (e * sig);
}

struct ChunkRaw { unsigned f[8], v[8], q[8]; u32x4 qm[2], km[2]; bf16x8 bS[4]; u32x2 g[4]; };
template <bool PASSC>
DI void chunk_load(ChunkRaw& r, const Params& p, int ch, int tid) {
    const int dp = tid & 63, wid = tid >> 6, lane = tid & 63, lr = lane & 15, lq = lane >> 4;
    const int b = ch >> 7, h = (ch >> 5) & 3, c = ch & 31, r0 = b * 2048 + c * 64;
    const bf16_t* z = (const bf16_t*)(p.ws + WS_Z);
    const bf16_t* S16 = (const bf16_t*)(p.ws + WS_U + 33554432) + (size_t)ch * 16384;
    const bf16_t* zrow = z + (size_t)(r0 + wid * 8) * DIN + h * 128 + 2 * dp;
    if (!PASSC) {
#pragma unroll
        for (int i = 0; i < 8; ++i) r.f[i] = *(const unsigned*)(zrow + (size_t)i * DIN + C_F);
#pragma unroll
        for (int i = 0; i < 8; ++i) r.q[i] = *(const unsigned*)(zrow + (size_t)i * DIN + C_Q);
    } else {
#pragma unroll
        for (int k = 0; k < 2; ++k) { const int u = tid + k * NT; const bf16_t* zr = z + (size_t)(r0 + (u >> 4)) * DIN + h * 128 + (u & 15) * 8;
            r.qm[k] = *(const u32x4*)(zr + C_Q); r.km[k] = *(const u32x4*)(zr + C_F); }
    }
#pragma unroll
    for (int i = 0; i < 8; ++i) r.v[i] = *(const unsigned*)(zrow + (size_t)i * DIN + C_I);
    if (PASSC) {
#pragma unroll
        for (int ks = 0; ks < 4; ++ks) r.bS[ks] = *(const bf16x8*)(S16 + (size_t)(wid * 16 + lr) * 128 + ks * 32 + lq * 8);
#pragma unroll
        for (int tt = 0; tt < 4; ++tt) r.g[tt] = *(const u32x2*)(z + (size_t)(r0 + tt * 16 + lr) * DIN + C_GB + h * 128 + wid * 16 + lq * 4);
    }
}
template <bool PASSC>
DI void hgrn_chunk(const ChunkRaw& raw, const Params& p, int l, int ch, unsigned char* lds, int tid) {
    const int dp = tid & 63, wid = tid >> 6, lane = tid & 63, lr = lane & 15, lq = lane >> 4, d0 = 2 * dp;
    const int b = ch >> 7, h = (ch >> 5) & 3, c = ch & 31, r0 = b * 2048 + c * 64;
    bf16_t* U16 = (bf16_t*)(p.ws + WS_U) + (size_t)ch * 16384;
    float* tot = (float*)(lds + L_TOT); float* eb = (float*)(lds + L_EB);
    const float lb0 = lb_of(p, l, h * 128 + d0), lb1 = lb_of(p, l, h * 128 + d0 + 1);
    const bf16x8 (&bS)[4] = raw.bS; const u32x2 (&graw)[4] = raw.g;
    float cs0[8], cs1[8], kk0[8], kk1[8]; float off0 = 0.f, off1 = 0.f, bref0 = 0.f, bref1 = 0.f, bL0 = 0.f, bL1 = 0.f;
    if (!PASSC) {
        float cum0 = 0.f, cum1 = 0.f;
#pragma unroll
        for (int i = 0; i < 8; ++i) { float f, k; gate_fk(__uint_as_float(raw.f[i] << 16), lb0, f, k); cum0 += __logf(f); cs0[i] = cum0; kk0[i] = k;
            gate_fk(__uint_as_float(raw.f[i] & 0xffff0000u), lb1, f, k); cum1 += __logf(f); cs1[i] = cum1; kk1[i] = k; }
        *(float2*)(tot + wid * 128 + d0) = make_float2(cum0, cum1);
        __syncthreads();
#pragma unroll
        for (int sgm = 0; sgm < 8; ++sgm) { const float2 tv = *(const float2*)(tot + sgm * 128 + d0);
            if (sgm < wid) { off0 += tv.x; off1 += tv.y; } if (sgm < 4) { bref0 += tv.x; bref1 += tv.y; } bL0 += tv.x; bL1 += tv.y; }
    }
    { u32x4 w0, w1;
#pragma unroll
      for (int j = 0; j < 4; ++j) { w0[j] = (raw.v[2 * j] & 0xffffu) | (raw.v[2 * j + 1] << 16); w1[j] = (raw.v[2 * j] >> 16) | (raw.v[2 * j + 1] & 0xffff0000u); }
      *(u32x4*)(lds + L_VT + d0 * 144 + wid * 16) = w0; *(u32x4*)(lds + L_VT + (d0 + 1) * 144 + wid * 16) = w1; }
    if (!PASSC) {
        float km0[8], km1[8];
        { bf16_t* zw = (bf16_t*)(p.ws + WS_Z) + (size_t)(r0 + wid * 8) * DIN + h * 128 + d0;
#pragma unroll
          for (int i = 0; i < 8; ++i) { const float b0 = fminf(fmaxf(off0 + cs0[i] - bref0, -80.f), 80.f), b1 = fminf(fmaxf(off1 + cs1[i] - bref1, -80.f), 80.f); const float e0 = __expf(b0), e1 = __expf(b1);
              km0[i] = kk0[i] * frcp(e0); km1[i] = kk1[i] * frcp(e1);
              *(unsigned*)(zw + (size_t)i * DIN + C_Q) = pk2(__uint_as_float(raw.q[i] << 16) * e0, __uint_as_float(raw.q[i] & 0xffff0000u) * e1);
              *(unsigned*)(zw + (size_t)i * DIN + C_F) = pk2(km0[i], km1[i]); } }
        u32x4 w0, w1;
#pragma unroll
        for (int j = 0; j < 4; ++j) { w0[j] = pk2(km0[2 * j], km0[2 * j + 1]); w1[j] = pk2(km1[2 * j], km1[2 * j + 1]); }
        *(u32x4*)(lds + L_ST + d0 * 144 + wid * 16) = w0; *(u32x4*)(lds + L_ST + (d0 + 1) * 144 + wid * 16) = w1;
        if (wid == 0) { *(float2*)((float*)(p.ws + WS_DEC) + (size_t)ch * 128 + d0) = make_float2(__expf(bL0), __expf(bL1));
            *(float2*)((float*)(p.ws + WS_EBR) + (size_t)ch * 128 + d0) = make_float2(__expf(bref0), __expf(bref1));
            *(float2*)(eb + d0) = make_float2(__expf(bL0 - bref0), __expf(bL1 - bref1)); }
        __syncthreads();
        f32x4 acc[8];
#pragma unroll
        for (int n = 0; n < 8; ++n) acc[n] = (f32x4){0.f, 0.f, 0.f, 0.f};
#pragma unroll
        for (int ks = 0; ks < 2; ++ks) {
            const bf16x8 bv = *(const bf16x8*)(lds + L_VT + (wid * 16 + lr) * 144 + (ks * 32 + lq * 8) * 2);
#pragma unroll
            for (int n = 0; n < 8; ++n) { const bf16x8 ak = *(const bf16x8*)(lds + L_ST + (n * 16 + lr) * 144 + (ks * 32 + lq * 8) * 2);
                acc[n] = __builtin_amdgcn_mfma_f32_16x16x32_bf16(ak, bv, acc[n], 0, 0, 0); }
        }
#pragma unroll
        for (int n = 0; n < 8; ++n) { const float4 sc = *(const float4*)(eb + n * 16 + lq * 4);
            u32x2 w2; w2.x = pk2(acc[n][0] * sc.x, acc[n][1] * sc.y); w2.y = pk2(acc[n][2] * sc.z, acc[n][3] * sc.w);
            *(u32x2*)(U16 + (size_t)(wid * 16 + lr) * 128 + n * 16 + lq * 4) = w2; }
        __syncthreads();
    } else {
#pragma unroll
        for (int k = 0; k < 2; ++k) { const int u = tid + k * NT; *(u32x4*)(lds + L_QM + (u >> 4) * 272 + (u & 15) * 16) = raw.qm[k]; *(u32x4*)(lds + L_KM + (u >> 4) * 272 + (u & 15) * 16) = raw.km[k]; }
        __syncthreads();
        { const int tt = wid >> 1;
#pragma unroll
          for (int jj = 0; jj < 2; ++jj) {
            const int st = (wid & 1) * 2 + jj; f32x4 acc = (f32x4){0.f, 0.f, 0.f, 0.f};
            if (st <= tt) {
#pragma unroll
                for (int ks = 0; ks < 4; ++ks) { const bf16x8 a = *(const bf16x8*)(lds + L_QM + (tt * 16 + lr) * 272 + (ks * 32 + lq * 8) * 2);
                    const bf16x8 bb = *(const bf16x8*)(lds + L_KM + (st * 16 + lr) * 272 + (ks * 32 + lq * 8) * 2);
                    acc = __builtin_amdgcn_mfma_f32_16x16x32_bf16(a, bb, acc, 0, 0, 0); }
            }
#pragma unroll
            for (int j = 0; j < 4; ++j) { const int t = tt * 16 + lq * 4 + j, s = st * 16 + lr;
                *(bf16_t*)(lds + L_AM + t * 144 + s * 2) = f2bf(s <= t ? acc[j] : 0.f); }
          } }
        __syncthreads();
        f32x4 acc[4];
        bf16x8 bV[2];
#pragma unroll
        for (int ks = 0; ks < 2; ++ks) bV[ks] = *(const bf16x8*)(lds + L_VT + (wid * 16 + lr) * 144 + (ks * 32 + lq * 8) * 2);
#pragma unroll
        for (int tt = 0; tt < 4; ++tt) {
            acc[tt] = (f32x4){0.f, 0.f, 0.f, 0.f};
#pragma unroll
            for (int ks = 0; ks < 4; ++ks) { const bf16x8 q = *(const bf16x8*)(lds + L_QM + (tt * 16 + lr) * 272 + (ks * 32 + lq * 8) * 2);
                acc[tt] = __builtin_amdgcn_mfma_f32_16x16x32_bf16(bS[ks], q, acc[tt], 0, 0, 0); }
#pragma unroll
            for (int ks = 0; ks < 2; ++ks) { if (ks * 32 <= tt * 16 + 15) { const bf16x8 am = *(const bf16x8*)(lds + L_AM + (tt * 16 + lr) * 144 + (ks * 32 + lq * 8) * 2);
                acc[tt] = __builtin_amdgcn_mfma_f32_16x16x32_bf16(bV[ks], am, acc[tt], 0, 0, 0); } }
        }
        float* ssq = (float*)(lds + L_ST);
#pragma unroll
        for (int tt = 0; tt < 4; ++tt) { float ss = acc[tt][0] * acc[tt][0] + acc[tt][1] * acc[tt][1] + acc[tt][2] * acc[tt][2] + acc[tt][3] * acc[tt][3];
            ss += __shfl_xor(ss, 16, 64); ss += __shfl_xor(ss, 32, 64);
            if (lq == 0) ssq[(tt * 16 + lr) * 8 + wid] = ss; }
        __syncthreads();
        bf16_t* mix = (bf16_t*)(p.ws + WS_XB);
        const float4 ng = *(const float4*)(p.hgrn_norm_g + l * 512 + h * 128 + wid * 16 + lq * 4);
#pragma unroll
        for (int tt = 0; tt < 4; ++tt) { const int t = tt * 16 + lr;
            const float4 s0 = *(const float4*)(ssq + t * 8), s1 = *(const float4*)(ssq + t * 8 + 4);
            const float rs = rsqrtf((s0.x + s0.y + s0.z + s0.w + s1.x + s1.y + s1.z + s1.w) * (1.0f / 128.0f) + EPS);
            const float g0 = __uint_as_float(graw[tt].x << 16), g1 = __uint_as_float(graw[tt].x & 0xffff0000u), g2 = __uint_as_float(graw[tt].y << 16), g3 = __uint_as_float(graw[tt].y & 0xffff0000u);
            u32x2 w2; w2.x = pk2(acc[tt][0] * rs * ng.x * silu(g0), acc[tt][1] * rs * ng.y * silu(g1)); w2.y = pk2(acc[tt][2] * rs * ng.z * silu(g2), acc[tt][3] * rs * ng.w * silu(g3));
            *(u32x2*)(mix + (size_t)(r0 + t) * DM + 256 + h * 128 + wid * 16 + lq * 4) = w2; }
        __syncthreads();
    }
}

template <bool PASSC>
DI void hgrn_pass(const Params& p, int l, unsigned char* lds) {
    const int tid = ltid();
    if (PASSC_PREFETCH || !PASSC) {
        ChunkRaw ra, rb;
        chunk_load<PASSC>(ra, p, (int)blockIdx.x, tid);
        chunk_load<PASSC>(rb, p, (int)blockIdx.x + GRID, tid);
        hgrn_chunk<PASSC>(ra, p, l, (int)blockIdx.x, lds, tid);
        chunk_load<PASSC>(ra, p, (int)blockIdx.x + 2 * GRID, tid);
        hgrn_chunk<PASSC>(rb, p, l, (int)blockIdx.x + GRID, lds, tid);
        chunk_load<PASSC>(rb, p, (int)blockIdx.x + 3 * GRID, tid);
        hgrn_chunk<PASSC>(ra, p, l, (int)blockIdx.x + 2 * GRID, lds, tid);
        hgrn_chunk<PASSC>(rb, p, l, (int)blockIdx.x + 3 * GRID, lds, tid);
    } else {
        for (int k = 0; k < 4; ++k) { ChunkRaw ra; chunk_load<PASSC>(ra, p, (int)blockIdx.x + k * GRID, tid); hgrn_chunk<PASSC>(ra, p, l, (int)blockIdx.x + k * GRID, lds, tid); }
    }
}

DI void phase_scan(const Params& p, int l, int idx_lo, int idx_hi, int stride) {
    const bf16_t* U16 = (const bf16_t*)(p.ws + WS_U); bf16_t* S16 = (bf16_t*)(p.ws + WS_U + 33554432);
    const float* dec = (const float*)(p.ws + WS_DEC); const float* ebr = (const float*)(p.ws + WS_EBR);
    for (int idx = idx_lo + ltid(); idx < idx_hi; idx += stride) {
        const int d4 = (idx & 31) * 4, e = (idx >> 5) & 127, bh = idx >> 12;
        float4 s = make_float4(0.f, 0.f, 0.f, 0.f);
        const size_t o0 = (size_t)bh * 32 * 16384 + e * 128 + d4; const float* pd0 = dec + (size_t)bh * 32 * 128 + d4; const float* pe0 = ebr + (size_t)bh * 32 * 128 + d4;
        for (int cb = 0; cb < 32; cb += 8) {
            u32x2 u[8]; float4 dc[8], ee[8];
#pragma unroll
            for (int j = 0; j < 8; ++j) { u[j] = *(const u32x2*)(U16 + o0 + (size_t)(cb + j) * 16384); dc[j] = *(const float4*)(pd0 + (cb + j) * 128); ee[j] = *(const float4*)(pe0 + (cb + j) * 128); }
#pragma unroll
            for (int j = 0; j < 8; ++j) { u32x2 w2; w2.x = pk2(s.x * ee[j].x, s.y * ee[j].y); w2.y = pk2(s.z * ee[j].z, s.w * ee[j].w);
                *(u32x2*)(S16 + o0 + (size_t)(cb + j) * 16384) = w2;
                s.x = dc[j].x * s.x + __uint_as_float(u[j].x << 16); s.y = dc[j].y * s.y + __uint_as_float(u[j].x & 0xffff0000u);
                s.z = dc[j].z * s.z + __uint_as_float(u[j].y << 16); s.w = dc[j].w * s.w + __uint_as_float(u[j].y & 0xffff0000u); }
        }
        float* o = p.out + O_NHP + (size_t)(l * 32 + bh) * 16384 + e;
        o[(d4 + 0) * 128] = s.x; o[(d4 + 1) * 128] = s.y; o[(d4 + 2) * 128] = s.z; o[(d4 + 3) * 128] = s.w;
    }
}

DI void sample_ld(const Params& p, int l, int item, int tid, float4 (&S)[8], bf16_t (&zs)[5]) {
    const int b = item >> 2, h = item & 3, e4 = (tid & 31) * 4, dg = tid >> 5;
    const float* S0 = p.state_hgrn + (size_t)((l * 128 + b) * 4 + h) * 16384;
    { const bf16_t* zr = (const bf16_t*)(p.ws + WS_Z) + (size_t)(MP + b * 4 + (tid >> 7)) * DIN + h * 128 + (tid & 127); zs[0] = zr[C_F]; zs[1] = zr[C_Q]; zs[2] = zr[C_I]; zs[3] = zr[C_GB]; zs[4] = 0; }
#pragma unroll
    for (int i = 0; i < 8; ++i) S[i] = ldnt4(S0 + (size_t)(dg + 16 * i) * 128 + e4);
}
DI void hgrn_sample(const Params& p, int l, int item, unsigned char* lds, int tid, float4 (&S)[8], const bf16_t (&zs)[5]) {
    const int b = item >> 2, h = item & 3, wid = tid >> 6, lane = tid & 63;
    const bf16_t* z = (const bf16_t*)(p.ws + WS_Z);
    float* sf = (float*)lds; float* sk = sf + 512; float* sq = sk + 512; float* sv = sq + 512; float* sg = sv + 512; float* red = sg + 512; float* ssq = red + 8192;
    { const int d = tid & 127;
      float f, k; gate_fk(bf2f(zs[0]), lb_of(p, l, h * 128 + d), f, k);
      sf[tid] = f; sk[tid] = k; sq[tid] = bf2f(zs[1]); sv[tid] = bf2f(zs[2]); sg[tid] = bf2f(zs[3]); }
    const int e4 = (tid & 31) * 4, dg = tid >> 5;
    float* S1 = p.out + O_NHS + (size_t)((l * 128 + b) * 4 + h) * 16384;
    __syncthreads();
#pragma unroll
    for (int t = 0; t < 4; ++t) {
        const float4 v = *(const float4*)(sv + t * 128 + e4); float4 a = make_float4(0.f, 0.f, 0.f, 0.f);
#pragma unroll
        for (int i = 0; i < 8; ++i) { const int d = t * 128 + dg + 16 * i; const float f = sf[d], k = sk[d], q = sq[d];
            S[i].x = f * S[i].x + k * v.x; S[i].y = f * S[i].y + k * v.y; S[i].z = f * S[i].z + k * v.z; S[i].w = f * S[i].w + k * v.w;
            a.x += q * S[i].x; a.y += q * S[i].y; a.z += q * S[i].z; a.w += q * S[i].w; }
        *(float4*)(red + (t * 16 + dg) * 128 + e4) = a;
    }
#pragma unroll
    for (int i = 0; i < 8; ++i) stnt4(S1 + (size_t)(dg + 16 * i) * 128 + e4, S[i]);
    __syncthreads();
    { const int t = tid >> 7, e = tid & 127; float o = 0.f;
#pragma unroll
      for (int g = 0; g < 16; ++g) o += red[(t * 16 + g) * 128 + e];
      const float ss = wave_sum(o * o);
      if (lane == 0) ssq[wid] = ss;
      __syncthreads();
      const float rs = rsqrtf((ssq[2 * t] + ssq[2 * t + 1]) * (1.0f / 128.0f) + EPS);
      ((bf16_t*)(p.ws + WS_XB))[(size_t)(MP + b * 4 + t) * DM + 256 + h * 128 + e] = f2bf(o * rs * p.hgrn_norm_g[l * 512 + h * 128 + e] * silu(sg[tid])); }
    __syncthreads();
}
DI void phase_sample(const Params& p, int l, unsigned char* lds) {
    const int tid = ltid(), bk = (int)blockIdx.x; float4 Sa[8], Sb[8]; bf16_t za[5], zb[5];
    sample_ld(p, l, bk, tid, Sa, za);
    if (bk >= 16) sample_ld(p, l, bk + GRID, tid, Sb, zb);
    hgrn_sample(p, l, bk, lds, tid, Sa, za);
    if (bk >= 32 && bk < 48) sample_ld(p, l, bk - 32 + GRID, tid, Sa, za);
    if (bk >= 16) hgrn_sample(p, l, bk + GRID, lds, tid, Sb, zb);
    if (bk >= 32 && bk < 48) hgrn_sample(p, l, bk - 32 + GRID, lds, tid, Sa, za);
}

DI Params load_params() {
    Params p{};
#if defined(__HIP_DEVICE_COMPILE__)
    typedef const __attribute__((address_space(4))) Params* KParams;
    KParams kp = (KParams)__builtin_amdgcn_kernarg_segment_ptr(); asm volatile("" : "+s"(kp));
    p.x_prompt = kp->x_prompt; p.x_sample = kp->x_sample; p.state_conv = kp->state_conv; p.state_hgrn = kp->state_hgrn; p.state_pool = kp->state_pool; p.norm_g = kp->norm_g; p.w_in = kp->w_in;
    p.conv_w = kp->conv_w; p.hgrn_lb = kp->hgrn_lb; p.hgrn_norm_g = kp->hgrn_norm_g; p.pool_w = kp->pool_w; p.pool_scale = kp->pool_scale; p.w_out = kp->w_out; p.final_norm_g = kp->final_norm_g;
    p.out = kp->out; p.ws = kp->ws;
#endif
    return p;
}
#define LP() load_params()
__global__ __launch_bounds__(512, 2) void hymba_fwd(Params p_unused) {
    extern __shared__ __attribute__((aligned(16))) unsigned char shm[];
    cg::grid_group grid = cg::this_grid();
    volatile LAS unsigned* xst = (volatile LAS unsigned*)(shm + 131072);
    if (threadIdx.x == 0) { xst[0] = 0u; xst[1] = 0u; xst[2] = 0u; xst[3] = 0u; }
    __syncthreads();
    { const Params p = LP(); (void)xcd_barrier_post((unsigned*)(p.ws + WS_BAR), xst); }
#define GSYNC() do { const Params p_ = LP(); XcdBarrier b_; b_.bar = (unsigned*)(p_.ws + WS_BAR); b_.x = xb_xcc_id(); b_.st = xst; xcd_barrier(b_); } while (0)
    { const Params p = LP(); phase_weights(p, shm, 0, 896, (int)blockIdx.x, (int)gridDim.x); }
    { const Params p = LP(); phase_norm0(p); }
    { const Params p = LP(); if (p.ws == nullptr) grid.sync(); }
    GSYNC();
    for (int l = 0; l < 2; ++l) {
        { const Params p = LP(); pg8::Gemm g; g.A = (const bf16_t*)(p.ws + (l == 0 ? WS_XB : WS_U)); g.Bt = (const bf16_t*)(p.ws + WS_WIN) + (size_t)l * DIN * DM; g.M = MT; g.N = DIN; g.K = DM;
          pg8::StaticOrder S; S.init(MT, DIN, (int)gridDim.x, (int)blockIdx.x); EpiZ E; E.O = (bf16_t*)(p.ws + WS_Z); E.ssq = l == 0 ? nullptr : (const float*)(p.ws + WS_SSQ) + (size_t)l * MT;
          pg8::gemm_phase<EpiZ, pg8::StaticOrder, false>((PG8_LAS unsigned char*)shm, g, S, E, nullptr);
        }
        if (blockIdx.x >= 156) { const Params p = LP(); phase_weights(p, shm, l == 0 ? 896 : 2048, l == 0 ? 2048 : 2304, (int)blockIdx.x - 156, (int)gridDim.x - 156); }
        GSYNC();
        { const Params p = LP(); hgrn_pass<false>(p, l, shm); }
        { const Params p = LP(); phase_sample(p, l, shm); }
        if (blockIdx.x >= 48 && blockIdx.x < 80) { const Params p = LP(); phase_conv(p, l, MP, MT, (int)blockIdx.x - 48, 32); }
        { const Params p = LP(); if (blockIdx.x < 16) phase_pool(p, l, shm, 512, 528, (int)blockIdx.x, 16, false); }
        GSYNC();
        if (blockIdx.x < 8) { const Params p = LP(); float* xs = p.out + O_Y + (size_t)MP * DM; pg8::Gemm g; g.A = (const bf16_t*)(p.ws + WS_XB) + (size_t)MP * DM; g.Bt = (const bf16_t*)(p.ws + WS_WOUT) + (size_t)l * DM * DM; g.M = MS; g.N = DM; g.K = DM;
          pg8::StaticOrder S; S.init(MS, DM, (int)gridDim.x, (int)blockIdx.x); EpiRes E; E.X = xs; E.src = l == 0 ? p.x_sample : xs; E.ssq = (float*)(p.ws + WS_SSQ) + (size_t)(l + 1) * MT + MP; E.xbn = l == 0 ? (bf16_t*)(p.ws + WS_XSN) : nullptr;
          pg8::gemm_phase<EpiRes, pg8::StaticOrder, false>((PG8_LAS unsigned char*)shm, g, S, E, nullptr); }
        { const Params p = LP(); phase_pool(p, l, shm, 0, 0, (int)blockIdx.x, (int)gridDim.x, true, true); }
        { unsigned nxt = 0u;
          if (threadIdx.x == 0) { const Params p = LP(); nxt = __hip_atomic_fetch_add((unsigned*)(p.ws + WS_BAR) + 3584 + 64 * l, 1u, __ATOMIC_RELAXED, __HIP_MEMORY_SCOPE_AGENT); }
          for (;;) {
              if (threadIdx.x == 0) xst[2] = nxt;
              __syncthreads();
              const int item = (int)xst[2];
              __syncthreads();
              if (item >= 1280) break;
              if (threadIdx.x == 0) { const Params p = LP(); nxt = __hip_atomic_fetch_add((unsigned*)(p.ws + WS_BAR) + 3584 + 64 * l, 1u, __ATOMIC_RELAXED, __HIP_MEMORY_SCOPE_AGENT); }
              if (item < 256) { const Params p = LP(); phase_scan(p, l, item * NT, item * NT + NT, NT); }
              else if (item < 768) { const Params p = LP(); phase_pool(p, l, shm, item - 256, item - 255, 0, 1, false, false); }
              else { const Params p = LP(); phase_conv_prompt(p, l, (item - 768) * 1024, (item - 768) * 1024 + 1024, NT); }
          } }
        GSYNC();
        { const Params p = LP(); hgrn_pass<true>(p, l, shm); }
        GSYNC();
        if (l == 0) { const Params p = LP(); const u32x4* cs = (const u32x4*)(p.ws + WS_XSN); u32x4* cd = (u32x4*)(p.ws + WS_U + (size_t)MP * DM * 2);
          for (int i = blockIdx.x * NT + ltid(); i < 65536; i += gridDim.x * NT) cd[i] = cs[i]; }
        { const Params p = LP(); float* xs = p.out + O_Y; pg8::Gemm g; g.A = (const bf16_t*)(p.ws + WS_XB); g.Bt = (const bf16_t*)(p.ws + WS_WOUT) + (size_t)l * DM * DM; g.M = MP; g.N = DM; g.K = DM;
          pg8::StaticOrder S; S.init(MP, DM, (int)gridDim.x, (int)blockIdx.x); EpiRes E; E.X = xs; E.src = l == 0 ? p.x_prompt : xs; E.ssq = (float*)(p.ws + WS_SSQ) + (size_t)(l + 1) * MT; E.xbn = l == 0 ? (bf16_t*)(p.ws + WS_U) : nullptr;
          pg8::gemm_phase<EpiRes, pg8::StaticOrder, false>((PG8_LAS unsigned char*)shm, g, S, E, nullptr); }
        GSYNC();
        if (l == 1) { const Params p = LP(); phase_final(p); }
    }
}

extern "C" void kernel_launch(void* const* d_in, const int* in_sizes, int n_in, void* d_out, int out_size, void* d_ws, size_t ws_size, hipStream_t stream) {
    static int grid = 0;
    if (grid == 0) {
        if (n_in != 14 || out_size != (int)O_END || ws_size < WS_END) { fprintf(stderr, "kernel_launch: unexpected shapes: n_in %d out %d ws %zu\n", n_in, out_size, ws_size); grid = -1; return; }
        int dev = 0, cus = 0, per_cu = 0;
        (void)hipGetDevice(&dev); (void)hipDeviceGetAttribute(&cus, hipDeviceAttributeMultiprocessorCount, dev);
        if (hipFuncSetAttribute((const void*)hymba_fwd, hipFuncAttributeMaxDynamicSharedMemorySize, LDS_BYTES) != hipSuccess) { fprintf(stderr, "kernel_launch: hipFuncSetAttribute failed\n"); grid = -1; return; }
        if (hipOccupancyMaxActiveBlocksPerMultiprocessor(&per_cu, (const void*)hymba_fwd, NT, LDS_BYTES) != hipSuccess || per_cu < 1) { fprintf(stderr, "kernel_launch: occupancy query failed (%d)\n", per_cu); (void)hipGetLastError(); per_cu = 1; }
        if (cus < GRID) { fprintf(stderr, "kernel_launch: built for a %d-CU device, found %d CUs\n", GRID, cus); grid = -1; return; }
        grid = GRID;
    }
    if (grid < 0) return;
    Params p{};
    p.x_prompt = (const float*)d_in[0]; p.x_sample = (const float*)d_in[1]; p.state_conv = (const float*)d_in[2]; p.state_hgrn = (const float*)d_in[3]; p.state_pool = (const float*)d_in[4];
    p.norm_g = (const float*)d_in[5]; p.w_in = (const float*)d_in[6]; p.conv_w = (const float*)d_in[7]; p.hgrn_lb = (const float*)d_in[8]; p.hgrn_norm_g = (const float*)d_in[9];
    p.pool_w = (const float*)d_in[10]; p.pool_scale = (const float*)d_in[11]; p.w_out = (const float*)d_in[12]; p.final_norm_g = (const float*)d_in[13];
    p.out = (float*)d_out; p.ws = (unsigned char*)d_ws;
    if (hipMemsetAsync((char*)d_ws + WS_BAR, 0, 16384, stream) != hipSuccess) { fprintf(stderr, "kernel_launch: memset of barrier words failed\n"); return; }
    void* args[] = {&p};
    const hipError_t e = hipLaunchCooperativeKernel((const void*)hymba_fwd, dim3(grid), dim3(NT), args, LDS_BYTES, stream);
    if (e != hipSuccess) fprintf(stderr, "kernel_launch: cooperative launch failed: %s (grid %d)\n", hipGetErrorString(e), grid);
}
```

```cpp
#include <hip/hip_runtime.h>
#include <hip/hip_cooperative_groups.h>
#include <cstdio>
namespace cg = cooperative_groups;
namespace pg8 {
#define PG8_LAS __attribute__((address_space(3)))
typedef unsigned short bf16_t;
typedef short bf16x8 __attribute__((ext_vector_type(8)));
typedef float f32x4 __attribute__((ext_vector_type(4)));
typedef unsigned u32x4 __attribute__((ext_vector_type(4)));
constexpr int BM = 256, BK = 64, HALF = 128, HTB = HALF * BK * 2  , STAGE_BYTES = 8 * HTB, NXCD = 8, WGM = 8;

__host__ __device__ __forceinline__ int lds_byte(int r, int c) { const int st = (r >> 4) * 2 + (c >> 5), rr = r & 15, cc = c & 31, ob = rr * 64 + cc * 2; return st * 1024 + (ob ^ (((ob >> 9) & 1) << 5)); }
__host__ __device__ __forceinline__ void stage_rc(int b, int& R, int& C) { const int st = b / 1024, sb = b % 1024, swz = sb ^ (((sb >> 9) & 1) << 5); R = (st >> 1) * 16 + swz / 64; C = (st & 1) * 32 + (swz % 64) / 2; }
__host__ __device__ __forceinline__ int perm32(int rho) { const int n = rho >> 4, i = rho & 15; return 8 * (i >> 2) + 4 * n + (i & 3); }

struct Unit { int pm, pn; };
struct Gemm { const bf16_t* A; const bf16_t* Bt; int M, N, K; };

struct StaticOrder {
    int nM, nN, nwg, G, c;
    __host__ __device__ void init(int M, int N, int G_, int c_) { nM = M / BM; nN = N / BM; nwg = nM * nN; G = G_; c = c_; }
    __host__ __device__ bool next(int i, Unit& u) const {
        const long L = (long)i * G + c; if (L >= nwg) return false;
        int wgid = (int)L; { const int q = nwg / NXCD, r = nwg % NXCD, xcd = wgid % NXCD, off = wgid / NXCD; wgid = (xcd < r ? xcd * (q + 1) : r * (q + 1) + (xcd - r) * q) + off; }
        const int nig = WGM * nN, gid = wgid / nig, fm = gid * WGM, gsz = (nM - fm) < WGM ? (nM - fm) : WGM;
        u.pm = fm + ((wgid % nig) % gsz); u.pn = (wgid % nig) / gsz; return true;
    }
    __device__ __forceinline__ void a_ready(const Unit&) const {}
    __device__ __forceinline__ void done(const Unit&) const {}
};
__device__ __forceinline__ unsigned cvt_pk_bf16(float lo, float hi) { unsigned r; asm volatile("v_cvt_pk_bf16_f32 %0, %1, %2" : "=v"(r) : "v"(lo), "v"(hi)); return r; }
template <class Epi, class Sched, bool STAMP = false>
__device__ __forceinline__ void gemm_phase(PG8_LAS unsigned char* lds, const Gemm g, const Sched& S, const Epi& E, unsigned long long* stamps) {
    int tid_l = threadIdx.x; asm volatile("" : "+v"(tid_l));
    const int tid = tid_l, wid = __builtin_amdgcn_readfirstlane(tid >> 6), lane = tid & 63, wr = wid >> 2, wc = wid & 3, fr = lane & 15, fq = lane >> 4;
    const int K = g.K, nt = K / BK;
    int ts_lo = 0, ts_hi = 0, nts = 0; const unsigned long long rt_entry = STAMP ? (unsigned long long)wall_clock64() : 0ull;
#define PG8_STAMP() do { if (STAMP && wid == 0 && nts < 64) { const unsigned long long _c = (unsigned long long)clock64(); \
        ts_lo = (lane == nts) ? (int)(unsigned)_c : ts_lo; ts_hi = (lane == nts) ? (int)(unsigned)(_c >> 32) : ts_hi; ++nts; } } while (0)
    PG8_STAMP();
    unsigned voffA[2], voffB[2];
#pragma unroll
    for (int i = 0; i < 2; ++i) { int R, C; stage_rc(tid * 16 + i * 8192, R, C); const int Rb = Epi::PERM ? ((R & ~31) + perm32(R & 31)) : R;
        voffA[i] = (unsigned)(R * K + C) * 2u; voffB[i] = (unsigned)(Rb * K + C) * 2u; }
    const size_t kstep = (size_t)(BK * 2);
    const size_t hstep = (size_t)HALF * K * 2;
    const size_t tstep = 2 * hstep;
    const unsigned ldsw = (unsigned)wid * 1024u;
    const int aoff = lds_byte(wr * 64 + fr, fq * 8), boff = lds_byte(wc * 32 + fr, fq * 8);
#define PG8_SA(b, h) (((b) * 2 + (h)) * HTB)
#define PG8_SB(b, h) ((4 + (b) * 2 + (h)) * HTB)
#define PG8_STAGE(bufoff, gbase, voff) do { _Pragma("unroll") for (int _i = 0; _i < 2; ++_i) \
        __builtin_amdgcn_global_load_lds((const unsigned*)((const char*)(gbase) + (voff)[_i]), (PG8_LAS unsigned*)(lds + (bufoff) + ldsw + _i * 8192), 16, 0, 0); } while (0)
#define PG8_LDA(dst, b, h) do { _Pragma("unroll") for (int m = 0; m < 4; ++m) _Pragma("unroll") for (int k = 0; k < 2; ++k) dst[m][k] = *(const PG8_LAS bf16x8*)(lds + PG8_SA(b, h) + aoff + m * 2048 + k * 1024); } while (0)
#define PG8_LDB(dst, b, h) do { _Pragma("unroll") for (int n = 0; n < 2; ++n) _Pragma("unroll") for (int k = 0; k < 2; ++k) dst[n][k] = *(const PG8_LAS bf16x8*)(lds + PG8_SB(b, h) + boff + n * 2048 + k * 1024); } while (0)
#define PG8_MMA(ai, bj, At, Bt) do { __builtin_amdgcn_s_setprio(1); _Pragma("unroll") for (int m = 0; m < 4; ++m) _Pragma("unroll") for (int n = 0; n < 2; ++n) _Pragma("unroll") for (int k = 0; k < 2; ++k) \
        acc[ai][bj][m][n] = __builtin_amdgcn_mfma_f32_16x16x32_bf16(Bt[n][k], At[m][k], acc[ai][bj][m][n], 0, 0, 0); __builtin_amdgcn_s_setprio(0); } while (0)
#define PG8_WAIT_V(n) asm volatile("s_waitcnt vmcnt(" #n ")" ::: "memory")
#define PG8_WAIT_L(n) asm volatile("s_waitcnt lgkmcnt(" #n ")" ::: "memory")
#define PG8_BAR __builtin_amdgcn_s_barrier()
#define PG8_SCHED __builtin_amdgcn_sched_barrier(0)
    Unit cur, nxt; int ui = 0;
    if (!S.next(0, cur)) return;
    f32x4 acc[2][2][4][2];
#pragma unroll
    for (int a = 0; a < 2; ++a)
#pragma unroll
        for (int b = 0; b < 2; ++b)
#pragma unroll
            for (int m = 0; m < 4; ++m)
#pragma unroll
                for (int n = 0; n < 2; ++n) acc[a][b][m][n] = (f32x4){0.f, 0.f, 0.f, 0.f};
    bf16x8 At[4][2], B0[2][2], B1[2][2];
    const char* cA = (const char*)g.A + (size_t)cur.pm * tstep; const char* cB = (const char*)g.Bt + (size_t)cur.pn * tstep;
    S.a_ready(cur);
    PG8_STAGE(PG8_SB(0, 0), cB, voffB); PG8_STAGE(PG8_SA(0, 0), cA, voffA); PG8_STAGE(PG8_SB(0, 1), cB + hstep, voffB); PG8_STAGE(PG8_SA(0, 1), cA + hstep, voffA);
    if (wr == 1) PG8_BAR;
    PG8_WAIT_V(4); PG8_BAR;
    PG8_STAGE(PG8_SB(1, 0), cB + kstep, voffB); PG8_STAGE(PG8_SA(1, 0), cA + kstep, voffA); PG8_STAGE(PG8_SB(1, 1), cB + hstep + kstep, voffB);
    PG8_WAIT_V(6); PG8_BAR;
    PG8_STAMP();
    for (;;) {
        const bool has_next = S.next(ui + 1, nxt);
        const char* nA = has_next ? (const char*)g.A + (size_t)nxt.pm * tstep : cA; const char* nB = has_next ? (const char*)g.Bt + (size_t)nxt.pn * tstep : cB;
        for (int t = 0; t < nt; t += 2) {
            const bool last = (t == nt - 2);
            const char* a1 = cA + (size_t)(t + 1) * kstep;
            const char* a2 = last ? nA : cA + (size_t)(t + 2) * kstep; const char* b2 = last ? nB : cB + (size_t)(t + 2) * kstep;
            const char* a3 = a2 + kstep; const char* b3 = b2 + kstep;
            if (last && has_next) S.a_ready(nxt);
            if (last) E.prefetch(cur, wr, fr, lds, wid);
            PG8_LDB(B0, 0, 0); PG8_SCHED; PG8_LDA(At, 0, 0); PG8_STAGE(PG8_SA(1, 1), a1 + hstep, voffA);
            PG8_WAIT_L(8); PG8_BAR; PG8_WAIT_L(0); PG8_MMA(0, 0, At, B0); PG8_BAR; PG8_SCHED;
            PG8_LDB(B1, 0, 1); PG8_STAGE(PG8_SB(0, 0), b2, voffB);
            PG8_BAR; PG8_WAIT_L(0); PG8_MMA(0, 1, At, B1); PG8_BAR;
            PG8_LDA(At, 0, 1); PG8_STAGE(PG8_SA(0, 0), a2, voffA);
            PG8_BAR; PG8_WAIT_L(0); PG8_MMA(1, 0, At, B0); PG8_BAR; PG8_SCHED;
            PG8_STAGE(PG8_SB(0, 1), b2 + hstep, voffB);
            PG8_WAIT_V(6); PG8_BAR; PG8_MMA(1, 1, At, B1); PG8_BAR;
            PG8_LDB(B0, 1, 0); PG8_SCHED; PG8_LDA(At, 1, 0); PG8_STAGE(PG8_SA(0, 1), a2 + hstep, voffA);
            PG8_WAIT_L(8); PG8_BAR; PG8_WAIT_L(0); PG8_MMA(0, 0, At, B0); PG8_BAR; PG8_SCHED;
            PG8_LDB(B1, 1, 1); PG8_STAGE(PG8_SB(1, 0), b3, voffB);
            PG8_BAR; PG8_WAIT_L(0); PG8_MMA(0, 1, At, B1); PG8_BAR;
            PG8_LDA(At, 1, 1); PG8_STAGE(PG8_SA(1, 0), a3, voffA);
            PG8_BAR; PG8_WAIT_L(0); PG8_MMA(1, 0, At, B0); PG8_BAR; PG8_SCHED;
            PG8_STAGE(PG8_SB(1, 1), b3 + hstep, voffB);
            PG8_WAIT_V(6); PG8_BAR; PG8_MMA(1, 1, At, B1); PG8_BAR;
        }
        PG8_STAMP();
        if constexpr (!Epi::AFTER_DRAIN) { E(acc, cur, wr, wc, fr, fq, lds, wid, lane); S.done(cur); }
        PG8_STAMP();
        if (!has_next) break;
#pragma unroll
        for (int a = 0; a < 2; ++a)
#pragma unroll
            for (int b = 0; b < 2; ++b)
#pragma unroll
                for (int m = 0; m < 4; ++m)
#pragma unroll
                    for (int n = 0; n < 2; ++n) acc[a][b][m][n] = (f32x4){0.f, 0.f, 0.f, 0.f};
        cur = nxt; cA = nA; cB = nB; ++ui;
    }
    PG8_WAIT_V(0);
    if (wr == 0) PG8_BAR;
    PG8_BAR;
    if constexpr (Epi::AFTER_DRAIN) { E.fused(acc, cur, wr, wc, fr, fq, lds, wid, lane); S.done(cur); }
    PG8_STAMP();
    if (STAMP && wid == 0) { stamps[lane] = lane < nts ? (((unsigned long long)(unsigned)ts_hi << 32) | (unsigned)ts_lo) : 0ull;
        if (lane == 62) stamps[62] = rt_entry; if (lane == 63) stamps[63] = (unsigned long long)wall_clock64(); }
#undef PG8_STAMP
#undef PG8_SA
#undef PG8_SB
#undef PG8_STAGE
#undef PG8_LDA
#undef PG8_LDB
#undef PG8_MMA
#undef PG8_WAIT_V
#undef PG8_WAIT_L
#undef PG8_BAR
#undef PG8_SCHED
}
}
#define XB_TMO      128
#define XB_XCNT(j)  (256  + 64 * (j))
#define XB_XSUB(j)  (1280 + 64 * (j))
#define XB_XGEN(j)  (2304 + 64 * (j))
#define XB_TOP      3328
#define XB_TOPGEN   3392
#define XCD_BAR_WORDS 3456
#define XB_SPIN_CAP (1u << 18)
#define LAS __attribute__((address_space(3)))

__device__ __forceinline__ unsigned xb_ld(unsigned* p)              { return __hip_atomic_load(p, __ATOMIC_RELAXED, __HIP_MEMORY_SCOPE_AGENT); }
__device__ __forceinline__ unsigned xb_add(unsigned* p, unsigned v) { return __hip_atomic_fetch_add(p, v, __ATOMIC_RELAXED, __HIP_MEMORY_SCOPE_AGENT); }
__device__ __forceinline__ unsigned xb_xcc_id() { return (unsigned)__builtin_amdgcn_s_getreg((3 << 11) | 20) & 0xFu; }
#define XB_SPIN(cond, bar) do { unsigned _sp = 0; while (cond) { __builtin_amdgcn_s_sleep(1); \
    if ((++_sp & 255u) == 0u) { if (xb_ld(&(bar)[XB_TMO])) break; if (_sp > XB_SPIN_CAP) { atomicAdd(&(bar)[XB_TMO], 1u); break; } } } } while (0)

struct XcdBarrier {
    unsigned* bar; unsigned x;
    volatile LAS unsigned* st;
};

__device__ __forceinline__ XcdBarrier xcd_barrier_post(unsigned* bar, volatile LAS unsigned* st) {
    XcdBarrier b; b.bar = bar; b.x = xb_xcc_id(); b.st = st;
    if (threadIdx.x == 0) (void)xb_add(&bar[XB_XCNT(b.x)], 1u);
    return b;
}
__device__ __forceinline__ void xcd_barrier_complete(unsigned* bar, unsigned x, unsigned& nloc, unsigned& nx) {
    const unsigned G = gridDim.x * gridDim.y * gridDim.z;
    unsigned sum, cnt, mine, sp = 0u;
    for (;;) {
        sum = 0u; cnt = 0u; mine = 0u;
#pragma unroll
        for (unsigned j = 0; j < 16; ++j) { const unsigned c = xb_ld(&bar[XB_XCNT(j)]); sum += c; cnt += (c > 0u) ? 1u : 0u; mine = (j == x) ? c : mine; }
        if (sum == G) break;
        __builtin_amdgcn_s_sleep(1);
        if ((++sp & 255u) == 0u) { if (xb_ld(&bar[XB_TMO])) break; if (sp > XB_SPIN_CAP) { atomicAdd(&bar[XB_TMO], 1u); break; } }
    }
    nloc = mine > 0u ? mine : 1u; nx = cnt > 0u ? cnt : 1u;
}

__device__ __forceinline__ void xcd_barrier(const XcdBarrier& b) {
    asm volatile("s_waitcnt vmcnt(0)" ::: "memory");
    __syncthreads();
    if (threadIdx.x == 0) {
        unsigned* bar = b.bar;
        __builtin_amdgcn_s_waitcnt(0);
        unsigned nloc = b.st[0], nx = b.st[1];
        if (nloc == 0u) { xcd_barrier_complete(bar, b.x, nloc, nx); b.st[0] = nloc; b.st[1] = nx; }
        const unsigned old = xb_add(&bar[XB_XSUB(b.x)], 1u);
        const unsigned gen = old / nloc;
        if (old + 1u == (gen + 1u) * nloc) {
            __builtin_amdgcn_fence(__ATOMIC_RELEASE, "agent");
            asm volatile("s_waitcnt vmcnt(0)" ::: "memory");
            const unsigned og = xb_add(&bar[XB_TOP], 1u);
            const unsigned tg = og / nx;
            if (og + 1u == (tg + 1u) * nx) xb_add(&bar[XB_TOPGEN], 1u);
            else XB_SPIN(xb_ld(&bar[XB_TOPGEN]) == tg, bar);
            __builtin_amdgcn_fence(__ATOMIC_ACQUIRE, "agent");
            xb_add(&bar[XB_XGEN(b.x)], 1u);
            asm volatile("s_waitcnt vmcnt(0)" ::: "memory");
        } else {
            XB_SPIN(xb_ld(&bar[XB_XGEN(b.x)]) == gen, bar);
            __builtin_amdgcn_fence(__ATOMIC_ACQUIRE, "agent");
            asm volatile("s_waitcnt vmcnt(0)" ::: "memory");
        }
    }
    __syncthreads();
}


#define DI __device__ __forceinline__
typedef pg8::bf16_t bf16_t;
typedef short bf16x8 __attribute__((ext_vector_type(8)));
typedef float f32x4 __attribute__((ext_vector_type(4)));
typedef unsigned u32x4 __attribute__((ext_vector_type(4)));
typedef unsigned u32x2 __attribute__((ext_vector_type(2)));

constexpr int MP = 16384, MS = 512, MT = MP + MS, DM = 1024, DIN = 3584, NT = 512;
constexpr int C_AH = 0, C_AB = 256, C_AC = 512, C_AG = 768, C_Q = 1024, C_F = 1536, C_I = 2048, C_GB = 2560, C_PV = 3072, C_PG = 3328;
constexpr float EPS = 1e-6f;
constexpr size_t O_Y = 0, O_NCP = 17301504, O_NHP = 17309696, O_NPP = 18358272, O_NCS = 18419712, O_NHS = 18550784, O_NPS = 35328000, O_END = 36311040;
constexpr size_t WS_WIN = 0, WS_WOUT = 14680064, WS_RSTD = 18874368, WS_DEC = 18941952, WS_XB = 19466240, WS_Z = 54069248, WS_U = 175179776, WS_BAR = 242288640, WS_SSQ = 242288640 + 16384, WS_XSN = 242288640 + 16384 + 3 * 67584, WS_EBR = 242288640 + 16384 + 3 * 67584 + 1048576, WS_PWT = 242288640 + 16384 + 3 * 67584 + 1048576 + 524288, WS_END = 242288640 + 16384 + 3 * 67584 + 1048576 + 524288 + 2 * 36864;
#ifndef PASSC_PREFETCH
#define PASSC_PREFETCH 1
#endif
constexpr int GRID = 256;
constexpr int EPF_OFF = 131072 + 64;
constexpr int LDS_BYTES = 131072 + 64 + 16384;
constexpr int L_QM = 0, L_KM = 17408, L_VT = 34816, L_ST = 53248, L_AM = 88064, L_TOT = 97280, L_EB = 101376, L_SSQ = 101888;

struct Params {
    const float *x_prompt, *x_sample, *state_conv, *state_hgrn, *state_pool, *norm_g, *w_in, *conv_w, *hgrn_lb, *hgrn_norm_g, *pool_w, *pool_scale, *w_out, *final_norm_g;
    float* out; unsigned char* ws;
};

DI float bf2f(bf16_t b) { return __uint_as_float(((unsigned)b) << 16); }
typedef __bf16 hbf2 __attribute__((ext_vector_type(2)));
typedef float hf2 __attribute__((ext_vector_type(2)));
DI unsigned pk2(float lo, float hi) { const hf2 v = {lo, hi}; return __builtin_bit_cast(unsigned, __builtin_convertvector(v, hbf2)); }
DI bf16_t f2bf(float f) { return (bf16_t)(pk2(f, f) & 0xffffu); }
DI float frcp(float x) { return __builtin_amdgcn_rcpf(x); }
DI void unpack8(u32x4 w, float (&o)[8]) {
    o[0] = __uint_as_float(w.x << 16); o[1] = __uint_as_float(w.x & 0xffff0000u); o[2] = __uint_as_float(w.y << 16); o[3] = __uint_as_float(w.y & 0xffff0000u);
    o[4] = __uint_as_float(w.z << 16); o[5] = __uint_as_float(w.z & 0xffff0000u); o[6] = __uint_as_float(w.w << 16); o[7] = __uint_as_float(w.w & 0xffff0000u);
}
DI int ltid() { int t = threadIdx.x; asm volatile("" : "+v"(t)); return t; }
DI float4 ldnt4(const float* p) { const f32x4 v = __builtin_nontemporal_load((const f32x4*)p); return make_float4(v[0], v[1], v[2], v[3]); }
DI void stnt4(float* p, float4 v) { const f32x4 w = {v.x, v.y, v.z, v.w}; __builtin_nontemporal_store(w, (f32x4*)p); }
DI float silu(float x) { return x * frcp(1.0f + __expf(-x)); }
DI float wave_sum(float v) {
#pragma unroll
    for (int o = 32; o >= 1; o >>= 1) v += __shfl_xor(v, o, 64);
    return v;
}

struct EpiZ {
    static constexpr bool PERM = true, AFTER_DRAIN = false;
    bf16_t* O; const float* ssq;
    DI void prefetch(const pg8::Unit& u, int wr, int fr, PG8_LAS unsigned char* lds, int wid) const {
        if (ssq) { const float* g = ssq + u.pm * 256 + wr * 64 + fr;
#pragma unroll
            for (int i = 0; i < 8; ++i) __builtin_amdgcn_global_load_lds((const unsigned*)(g + (i >> 2) * 128 + (i & 3) * 16), (PG8_LAS unsigned*)(lds + EPF_OFF + wid * 2048 + i * 256), 4, 0, 0); }
    }
    DI void operator()(const f32x4 (&acc)[2][2][4][2], const pg8::Unit& u, int wr, int wc, int fr, int fq, PG8_LAS unsigned char* lds, int wid, int lane) const {
        const int row0 = u.pm * 256 + wr * 64 + fr, col0 = u.pn * 256 + wc * 32 + 8 * fq;
#pragma unroll
        for (int ai = 0; ai < 2; ++ai)
#pragma unroll
            for (int m = 0; m < 4; ++m) {
                const int r = row0 + ai * 128 + m * 16; const float s = ssq ? rsqrtf(*(const PG8_LAS float*)(lds + EPF_OFF + wid * 2048 + (ai * 4 + m) * 256 + lane * 4) * (1.0f / DM) + EPS) : 1.0f; bf16_t* rowp = O + (size_t)r * DIN + col0;
#pragma unroll
                for (int bj = 0; bj < 2; ++bj) { const f32x4 v0 = acc[ai][bj][m][0] * s, v1 = acc[ai][bj][m][1] * s;
                    u32x4 w; w.x = pg8::cvt_pk_bf16(v0[0], v0[1]); w.y = pg8::cvt_pk_bf16(v0[2], v0[3]); w.z = pg8::cvt_pk_bf16(v1[0], v1[1]); w.w = pg8::cvt_pk_bf16(v1[2], v1[3]);
                    *(u32x4*)(rowp + bj * 128) = w; } }
    }
};
struct EpiRes {
    static constexpr bool PERM = false, AFTER_DRAIN = true;
    float* X; const float* src; float* ssq; bf16_t* xbn;
    DI void prefetch(const pg8::Unit&, int, int, PG8_LAS unsigned char*, int) const {}
    DI void operator()(const f32x4 (&)[2][2][4][2], const pg8::Unit&, int, int, int, int, PG8_LAS unsigned char*, int, int) const {}
    DI void fused(const f32x4 (&acc)[2][2][4][2], const pg8::Unit& u, int wr, int wc, int fr, int fq, PG8_LAS unsigned char* lds, int wid, int lane) const {
        typedef PG8_LAS f32x4* LP4;
#pragma unroll
        for (int ai = 0; ai < 2; ++ai) {
#pragma unroll
            for (int m = 0; m < 4; ++m) { const int rl = wr * 64 + m * 16 + fr;
#pragma unroll
                for (int bj = 0; bj < 2; ++bj)
#pragma unroll
                    for (int n = 0; n < 2; ++n) { const int c4 = bj * 32 + wc * 8 + n * 4 + fq; *(LP4)(lds + rl * 1024 + ((c4 ^ (rl & 15)) << 4)) = acc[ai][bj][m][n]; } }
            __syncthreads();
#pragma unroll
            for (int half = 0; half < 2; ++half) {
                f32x4 sv[8];
#pragma unroll
                for (int rr = 0; rr < 8; ++rr) { const int row = wid * 16 + half * 8 + rr; const size_t go = (size_t)(u.pm * 256 + ai * 128 + row) * DM + u.pn * 256 + lane * 4; sv[rr] = __builtin_nontemporal_load((const f32x4*)(src + go)); }
                float part[8];
#pragma unroll
                for (int rr = 0; rr < 8; ++rr) { const int row = wid * 16 + half * 8 + rr; const int gr = u.pm * 256 + ai * 128 + row; const size_t go = (size_t)gr * DM + u.pn * 256 + lane * 4;
                    const f32x4 o = sv[rr] + *(LP4)(lds + row * 1024 + ((lane ^ (row & 15)) << 4));
                    *(f32x4*)(X + go) = o;
                    if (xbn) { u32x2 w; w.x = pk2(o[0], o[1]); w.y = pk2(o[2], o[3]); *(u32x2*)(xbn + go) = w; }
                    part[rr] = o[0] * o[0] + o[1] * o[1] + o[2] * o[2] + o[3] * o[3]; }
                { const bool h1 = (lane & 32) != 0, h2 = (lane & 16) != 0, h3 = (lane & 8) != 0; float q4[4], q2[2];
#pragma unroll
                  for (int i = 0; i < 4; ++i) { const float snd = h1 ? part[i] : part[i + 4], kp = h1 ? part[i + 4] : part[i]; q4[i] = kp + __shfl_xor(snd, 32, 64); }
#pragma unroll
                  for (int i = 0; i < 2; ++i) { const float snd = h2 ? q4[i] : q4[i + 2], kp = h2 ? q4[i + 2] : q4[i]; q2[i] = kp + __shfl_xor(snd, 16, 64); }
                  float q1; { const float snd = h3 ? q2[0] : q2[1], kp = h3 ? q2[1] : q2[0]; q1 = kp + __shfl_xor(snd, 8, 64); }
                  q1 += __shfl_xor(q1, 4, 64); q1 += __shfl_xor(q1, 2, 64); q1 += __shfl_xor(q1, 1, 64);
                  const int rsel = (h3 ? 1 : 0) + (h2 ? 2 : 0) + (h1 ? 4 : 0);
                  if ((lane & 7) == 0) (void)__hip_atomic_fetch_add(ssq + u.pm * 256 + ai * 128 + wid * 16 + half * 8 + rsel, q1, __ATOMIC_RELAXED, __HIP_MEMORY_SCOPE_AGENT); }
            }
            __syncthreads();
        }
    }
};

struct WTile { const float* src; bf16_t* dst; const float* g; int N, kt, nt; };
DI WTile wtile_of(const Params& p, int ti) {
    constexpr int T_IN = 2 * 16 * 56; WTile w;
    bf16_t* win = (bf16_t*)(p.ws + WS_WIN); bf16_t* wout = (bf16_t*)(p.ws + WS_WOUT);
    if (ti < T_IN) { const int l = ti / (16 * 56), r = ti % (16 * 56); w.kt = r / 56; w.nt = r % 56; w.N = DIN; w.src = p.w_in + (size_t)l * DM * DIN; w.dst = win + (size_t)l * DIN * DM; w.g = p.norm_g + l * DM; }
    else { const int tt = ti - T_IN; const int l = tt / 256, r = tt % 256; w.kt = r / 16; w.nt = r % 16; w.N = DM; w.src = p.w_out + (size_t)l * DM * DM; w.dst = wout + (size_t)l * DM * DM; w.g = nullptr; }
    return w;
}
DI void wtile_ld(const WTile& w, int tid, float4 (&v)[2], float (&gg)[2]) {
#pragma unroll
    for (int i = 0; i < 2; ++i) { const int k = (tid >> 4) + 32 * i, n4 = (tid & 15) * 4;
        v[i] = ldnt4(w.src + (size_t)(w.kt * 64 + k) * w.N + w.nt * 64 + n4); gg[i] = w.g ? w.g[w.kt * 64 + k] : 1.0f; }
}
DI void phase_weights(const Params& p, unsigned char* lds, int ti_lo, int T_ALL, int blk, int nblk) {
    const int tid = ltid(); float* t = (float*)lds;
    float4 v[2]; float gg[2];
    int ti = ti_lo + blk;
    if (ti < T_ALL) { const WTile w = wtile_of(p, ti); wtile_ld(w, tid, v, gg); }
    for (; ti < T_ALL; ti += nblk) {
        const WTile w = wtile_of(p, ti);
#pragma unroll
        for (int i = 0; i < 2; ++i) { const int k = (tid >> 4) + 32 * i, n4 = (tid & 15) * 4;
            t[k * 65 + n4 + 0] = v[i].x * gg[i]; t[k * 65 + n4 + 1] = v[i].y * gg[i]; t[k * 65 + n4 + 2] = v[i].z * gg[i]; t[k * 65 + n4 + 3] = v[i].w * gg[i]; }
        if (ti + nblk < T_ALL) { const WTile wn = wtile_of(p, ti + nblk); wtile_ld(wn, tid, v, gg); }
        __syncthreads();
        { const int n = tid >> 3, k8 = (tid & 7) * 8; u32x4 o;
          o.x = pk2(t[(k8 + 0) * 65 + n], t[(k8 + 1) * 65 + n]); o.y = pk2(t[(k8 + 2) * 65 + n], t[(k8 + 3) * 65 + n]);
          o.z = pk2(t[(k8 + 4) * 65 + n], t[(k8 + 5) * 65 + n]); o.w = pk2(t[(k8 + 6) * 65 + n], t[(k8 + 7) * 65 + n]);
          *(u32x4*)(w.dst + (size_t)(w.nt * 64 + n) * DM + w.kt * 64 + k8) = o; }
        __syncthreads();
    }
}

DI void phase_norm0(const Params& p) {
    const int tid_ = ltid(), wid = tid_ >> 6, lane = tid_ & 63;
    bf16_t* xb = (bf16_t*)(p.ws + WS_XB); float* ssq = (float*)(p.ws + WS_SSQ);
    for (int i = blockIdx.x * NT + tid_; i < 2 * MT; i += gridDim.x * NT) ssq[MT + i] = 0.f;
    for (int i = blockIdx.x * NT + tid_; i < 2 * 16384; i += gridDim.x * NT) { const int l = i >> 14, r = i & 16383, g = r >> 12, c = (r >> 6) & 63, d = r & 63;
        *(bf16_t*)(p.ws + WS_PWT + (size_t)l * 36864 + (g * 64 + d) * 144 + c * 2) = f2bf(p.pool_w[i]); }
    const int rstride = gridDim.x * 8;
    for (int row = blockIdx.x * 8 + wid; row < MT; row += 2 * rstride) {
        const int row2 = row + rstride; const bool two = row2 < MT; const int rb = two ? row2 : row;
        const float* sa = row < MP ? p.x_prompt + (size_t)row * DM : p.x_sample + (size_t)(row - MP) * DM;
        const float* sb = rb < MP ? p.x_prompt + (size_t)rb * DM : p.x_sample + (size_t)(rb - MP) * DM;
        float4 va[4], vb[4]; float ssa = 0.f, ssb = 0.f;
#pragma unroll
        for (int i = 0; i < 4; ++i) { va[i] = ldnt4(sa + i * 256 + lane * 4); vb[i] = ldnt4(sb + i * 256 + lane * 4); }
#pragma unroll
        for (int i = 0; i < 4; ++i) { ssa += va[i].x * va[i].x + va[i].y * va[i].y + va[i].z * va[i].z + va[i].w * va[i].w; ssb += vb[i].x * vb[i].x + vb[i].y * vb[i].y + vb[i].z * vb[i].z + vb[i].w * vb[i].w; }
        ssa = wave_sum(ssa); ssb = wave_sum(ssb);
        const float ra = rsqrtf(ssa * (1.0f / DM) + EPS), rb2 = rsqrtf(ssb * (1.0f / DM) + EPS);
#pragma unroll
        for (int i = 0; i < 4; ++i) { u32x2 w; w.x = pk2(va[i].x * ra, va[i].y * ra); w.y = pk2(va[i].z * ra, va[i].w * ra); *(u32x2*)(xb + (size_t)row * DM + i * 256 + lane * 4) = w;
            if (two) { u32x2 w2; w2.x = pk2(vb[i].x * rb2, vb[i].y * rb2); w2.y = pk2(vb[i].z * rb2, vb[i].w * rb2); *(u32x2*)(xb + (size_t)row2 * DM + i * 256 + lane * 4) = w2; } }
    }
}
DI void phase_final(const Params& p) {
    float* xs = p.out + O_Y; const float* ssq = (const float*)(p.ws + WS_SSQ) + 2 * MT;
    const int stride = gridDim.x * NT;
    for (int i0 = blockIdx.x * NT + ltid(); i0 < MT * 256; i0 += 8 * stride) {
        float4 v[8]; float r[8];
#pragma unroll
        for (int k = 0; k < 8; ++k) { const int idx = i0 + k * stride; if (idx < MT * 256) { v[k] = ldnt4(xs + (size_t)idx * 4); r[k] = ssq[idx >> 8]; } }
#pragma unroll
        for (int k = 0; k < 8; ++k) { const int idx = i0 + k * stride; if (idx < MT * 256) { const float rr = rsqrtf(r[k] * (1.0f / DM) + EPS);
            const float4 g = *(const float4*)(p.final_norm_g + (idx & 255) * 4); float4 o = v[k];
            o.x *= rr * g.x; o.y *= rr * g.y; o.z *= rr * g.z; o.w *= rr * g.w; stnt4(xs + (size_t)idx * 4, o); } }
    }
}

DI void phase_conv(const Params& p, int l, int row_lo, int row_hi, int blk, int nblk) {
    const bf16_t* z = (const bf16_t*)(p.ws + WS_Z); bf16_t* mix = (bf16_t*)(p.ws + WS_XB);
    const float* cw = p.conv_w + l * 3 * 256;
    for (int idx = row_lo * 32 + blk * NT + ltid(); idx < row_hi * 32; idx += nblk * NT) {
        const int row = idx >> 5, c = (idx & 31) * 8;
        int t, T; const float* buf; float* nc;
        if (row < MP) { const int b = row >> 11; t = row & 2047; T = 2048; buf = nullptr; nc = p.out + O_NCP + (size_t)(l * 8 + b) * 512; }
        else { const int rr = row - MP; const int b = rr >> 2; t = rr & 3; T = 4; buf = p.state_conv + (size_t)(l * 128 + b) * 512; nc = p.out + O_NCS + (size_t)(l * 128 + b) * 512; }
        float u[3][8];
#pragma unroll
        for (int j = 0; j < 3; ++j) {
            const int tp = t - 2 + j;
            if (tp >= 0) { const bf16_t* zr = z + (size_t)(row - 2 + j) * DIN + c; float ah[8], ac[8]; unpack8(*(const u32x4*)(zr + C_AH), ah); unpack8(*(const u32x4*)(zr + C_AC), ac);
#pragma unroll
                for (int i = 0; i < 8; ++i) u[j][i] = ah[i] * ac[i]; }
            else if (buf) { const float4 a = *(const float4*)(buf + (tp + 2) * 256 + c), b4 = *(const float4*)(buf + (tp + 2) * 256 + c + 4);
                u[j][0] = a.x; u[j][1] = a.y; u[j][2] = a.z; u[j][3] = a.w; u[j][4] = b4.x; u[j][5] = b4.y; u[j][6] = b4.z; u[j][7] = b4.w; }
            else {
#pragma unroll
                for (int i = 0; i < 8; ++i) u[j][i] = 0.f; }
        }
        const bf16_t* zr = z + (size_t)row * DIN + c; float ab[8], ag[8]; unpack8(*(const u32x4*)(zr + C_AB), ab); unpack8(*(const u32x4*)(zr + C_AG), ag);
        float w0[8], w1[8], w2[8];
        { const float4 a0 = *(const float4*)(cw + c), a1 = *(const float4*)(cw + c + 4), b0 = *(const float4*)(cw + 256 + c), b1 = *(const float4*)(cw + 256 + c + 4), c0 = *(const float4*)(cw + 512 + c), c1 = *(const float4*)(cw + 512 + c + 4);
          w0[0] = a0.x; w0[1] = a0.y; w0[2] = a0.z; w0[3] = a0.w; w0[4] = a1.x; w0[5] = a1.y; w0[6] = a1.z; w0[7] = a1.w;
          w1[0] = b0.x; w1[1] = b0.y; w1[2] = b0.z; w1[3] = b0.w; w1[4] = b1.x; w1[5] = b1.y; w1[6] = b1.z; w1[7] = b1.w;
          w2[0] = c0.x; w2[1] = c0.y; w2[2] = c0.z; w2[3] = c0.w; w2[4] = c1.x; w2[5] = c1.y; w2[6] = c1.z; w2[7] = c1.w; }
        float o[8];
#pragma unroll
        for (int i = 0; i < 8; ++i) { const float y = w0[i] * u[0][i] + w1[i] * u[1][i] + w2[i] * u[2][i]; o[i] = ab[i] * y * silu(ag[i]); }
        u32x4 w; w.x = pk2(o[0], o[1]); w.y = pk2(o[2], o[3]); w.z = pk2(o[4], o[5]); w.w = pk2(o[6], o[7]);
        *(u32x4*)(mix + (size_t)row * DM + c) = w;
        if (t >= T - 2) { float* d = nc + (t - (T - 2)) * 256 + c; *(float4*)d = make_float4(u[2][0], u[2][1], u[2][2], u[2][3]); *(float4*)(d + 4) = make_float4(u[2][4], u[2][5], u[2][6], u[2][7]); }
    }
}

DI void conv_ld(const bf16_t* z, int idx, u32x4 (&r)[8]) {
    const int row = idx >> 5, c = (idx & 31) * 8, t = row & 2047; const bf16_t* zr = z + (size_t)row * DIN + c;
#pragma unroll
    for (int j = 0; j < 3; ++j) { const bf16_t* q = zr - (size_t)((t - 2 + j >= 0) ? (2 - j) * DIN : 0); r[2 * j] = *(const u32x4*)(q + C_AH); r[2 * j + 1] = *(const u32x4*)(q + C_AC); }
    r[6] = *(const u32x4*)(zr + C_AB); r[7] = *(const u32x4*)(zr + C_AG);
}
DI void conv_fin(const Params& p, int l, int idx, const u32x4 (&r)[8]) {
    const int row = idx >> 5, c = (idx & 31) * 8, t = row & 2047; const float* cw = p.conv_w + l * 3 * 256;
    float u[3][8];
#pragma unroll
    for (int j = 0; j < 3; ++j) { float ah[8], ac[8]; unpack8(r[2 * j], ah); unpack8(r[2 * j + 1], ac); const float m = (t - 2 + j >= 0) ? 1.f : 0.f;
#pragma unroll
        for (int i = 0; i < 8; ++i) u[j][i] = ah[i] * ac[i] * m; }
    float ab[8], ag[8]; unpack8(r[6], ab); unpack8(r[7], ag);
    float w0[8], w1[8], w2[8];
    { const float4 a0 = *(const float4*)(cw + c), a1 = *(const float4*)(cw + c + 4), b0 = *(const float4*)(cw + 256 + c), b1 = *(const float4*)(cw + 256 + c + 4), c0 = *(const float4*)(cw + 512 + c), c1 = *(const float4*)(cw + 512 + c + 4);
      w0[0] = a0.x; w0[1] = a0.y; w0[2] = a0.z; w0[3] = a0.w; w0[4] = a1.x; w0[5] = a1.y; w0[6] = a1.z; w0[7] = a1.w;
      w1[0] = b0.x; w1[1] = b0.y; w1[2] = b0.z; w1[3] = b0.w; w1[4] = b1.x; w1[5] = b1.y; w1[6] = b1.z; w1[7] = b1.w;
      w2[0] = c0.x; w2[1] = c0.y; w2[2] = c0.z; w2[3] = c0.w; w2[4] = c1.x; w2[5] = c1.y; w2[6] = c1.z; w2[7] = c1.w; }
    float o[8];
#pragma unroll
    for (int i = 0; i < 8; ++i) { const float y = w0[i] * u[0][i] + w1[i] * u[1][i] + w2[i] * u[2][i]; o[i] = ab[i] * y * silu(ag[i]); }
    u32x4 w; w.x = pk2(o[0], o[1]); w.y = pk2(o[2], o[3]); w.z = pk2(o[4], o[5]); w.w = pk2(o[6], o[7]);
    *(u32x4*)((bf16_t*)(p.ws + WS_XB) + (size_t)row * DM + c) = w;
    if (t >= 2046) { float* d = p.out + O_NCP + (size_t)(l * 8 + (row >> 11)) * 512 + (t - 2046) * 256 + c; *(float4*)d = make_float4(u[2][0], u[2][1], u[2][2], u[2][3]); *(float4*)(d + 4) = make_float4(u[2][4], u[2][5], u[2][6], u[2][7]); }
}
DI void phase_conv_prompt(const Params& p, int l, int idx_lo, int idx_hi, int stride) {
    const bf16_t* z = (const bf16_t*)(p.ws + WS_Z);
    for (int idx = idx_lo + ltid(); idx < idx_hi; idx += 2 * stride) {
        u32x4 ra[8], rb[8]; const bool two = idx + stride < idx_hi;
        conv_ld(z, idx, ra); conv_ld(z, two ? idx + stride : idx, rb);
        conv_fin(p, l, idx, ra); if (two) conv_fin(p, l, idx + stride, rb);
    }
}

DI void pool_ld(const bf16_t* z, int tile, int tid, u32x4 (&vld)[3], u32x4 (&gld)[2]) {
    const int row0 = tile * 32, t0 = row0 & 2047;
#pragma unroll
    for (int k = 0; k < 3; ++k) { const int it = tid + k * NT, rr = it >> 5, c = (it & 31) * 8; vld[k] = (u32x4){0u, 0u, 0u, 0u};
        if (it < 47 * 32 && t0 - 15 + rr >= 0) vld[k] = *(const u32x4*)(z + (size_t)(row0 - 15 + rr) * DIN + C_PV + c); }
#pragma unroll
    for (int k = 0; k < 2; ++k) { const int it = tid + k * NT, tl = it >> 5, c = (it & 31) * 8; gld[k] = *(const u32x4*)(z + (size_t)(row0 + tl) * DIN + C_PG + c); }
}
DI void phase_pool(const Params& p, int l, unsigned char* lds, int tile_lo, int tile_hi, int blk, int nblk, bool do_bufs, bool setup = true) {
    const int tid = ltid(), wid = tid >> 6, lane = tid & 63, lr = lane & 15, lq = lane >> 4;
    const bf16_t* z = (const bf16_t*)(p.ws + WS_Z); bf16_t* mix = (bf16_t*)(p.ws + WS_XB);
    constexpr int P_PWT = 0, P_UB = 36864, P_GT = 53760, P_OB = 87040, P_VT = 103936;
    float* gt = (float*)(lds + P_GT);
    __syncthreads();
    if (setup) { const u32x4* img = (const u32x4*)(p.ws + WS_PWT + (size_t)l * 36864);
      for (int i = tid; i < 2304; i += NT) *(u32x4*)(lds + P_PWT + i * 16) = img[i]; }
    u32x4 vld[3], gld[2];
    if (tile_lo + blk < tile_hi && tile_lo + blk < 512) pool_ld(z, tile_lo + blk, tid, vld, gld);
    for (int tile = tile_lo + blk; tile < tile_hi; tile += nblk) {
        __syncthreads();
        if (tile < 512) {
            const int row0 = tile * 32, t0 = row0 & 2047;
#pragma unroll
            for (int k = 0; k < 3; ++k) { const int it = tid + k * NT, rr = it >> 5, c = (it & 31) * 8; if (it < 47 * 32) *(u32x4*)(lds + P_VT + rr * 528 + c * 2) = vld[k]; }
#pragma unroll
            for (int k = 0; k < 2; ++k) { const int it = tid + k * NT, tl = it >> 5, c = (it & 31) * 8;
                float g[8]; unpack8(gld[k], g);
                const float4 s0 = *(const float4*)(p.pool_scale + l * 256 + c), s1 = *(const float4*)(p.pool_scale + l * 256 + c + 4);
                *(float4*)(gt + tl * 260 + c) = make_float4(s0.x * silu(g[0]), s0.y * silu(g[1]), s0.z * silu(g[2]), s0.w * silu(g[3]));
                *(float4*)(gt + tl * 260 + c + 4) = make_float4(s1.x * silu(g[4]), s1.y * silu(g[5]), s1.z * silu(g[6]), s1.w * silu(g[7])); }
            if (tile + nblk < tile_hi && tile + nblk < 512) pool_ld(z, tile + nblk, tid, vld, gld);
            __syncthreads();
#pragma unroll
            for (int k = 0; k < 2; ++k) { const int it = tid + k * NT, tl = it >> 5, c = (it & 31) * 8, gi = c >> 6, w = 2 << gi;
                float s[8], cur[8];
                unpack8(*(const u32x4*)(lds + P_VT + (tl + 15) * 528 + c * 2), cur);
#pragma unroll
                for (int i = 0; i < 8; ++i) s[i] = cur[i];
                for (int j = 1; j < w; ++j) { float v[8]; unpack8(*(const u32x4*)(lds + P_VT + (tl + 15 - j) * 528 + c * 2), v);
#pragma unroll
                    for (int i = 0; i < 8; ++i) s[i] += v[i]; }
                const float inv = frcp((float)min(w, t0 + tl + 1));
                u32x4 uw; uw.x = pk2(s[0] * inv - cur[0], s[1] * inv - cur[1]); uw.y = pk2(s[2] * inv - cur[2], s[3] * inv - cur[3]);
                uw.z = pk2(s[4] * inv - cur[4], s[5] * inv - cur[5]); uw.w = pk2(s[6] * inv - cur[6], s[7] * inv - cur[7]);
                *(u32x4*)(lds + P_UB + tl * 528 + c * 2) = uw; }
        } else {
            for (int it = tid; it < 1024; it += NT) {
                const int tl = it >> 5, c = (it & 31) * 8, gi = c >> 6, w = 2 << gi;
                const int row = MP + (tile - 512) * 32 + tl, rr = row - MP, t = rr & 3; const float* buf = p.state_pool + (size_t)(l * 128 + (rr >> 2)) * 15 * 256;
                float s[8], cur[8];
                unpack8(*(const u32x4*)(z + (size_t)row * DIN + C_PV + c), cur);
#pragma unroll
                for (int i = 0; i < 8; ++i) s[i] = cur[i];
#pragma unroll
                for (int j = 1; j < 4; ++j) { float v[8]; unpack8(*(const u32x4*)(z + (size_t)(row - min(j, t)) * DIN + C_PV + c), v); const float m = (j <= t && j < w) ? 1.f : 0.f;
#pragma unroll
                    for (int i = 0; i < 8; ++i) s[i] += m * v[i]; }
#pragma unroll
                for (int j = 1; j < 16; ++j) { const int tp = t - j, bi = tp < 0 ? 15 + tp : 0; const float m = (tp < 0 && j < w) ? 1.f : 0.f;
                    const float4 a = *(const float4*)(buf + bi * 256 + c), b4 = *(const float4*)(buf + bi * 256 + c + 4);
                    s[0] += m * a.x; s[1] += m * a.y; s[2] += m * a.z; s[3] += m * a.w; s[4] += m * b4.x; s[5] += m * b4.y; s[6] += m * b4.z; s[7] += m * b4.w; }
                const float inv = frcp((float)w);
                u32x4 uw; uw.x = pk2(s[0] * inv - cur[0], s[1] * inv - cur[1]); uw.y = pk2(s[2] * inv - cur[2], s[3] * inv - cur[3]);
                uw.z = pk2(s[4] * inv - cur[4], s[5] * inv - cur[5]); uw.w = pk2(s[6] * inv - cur[6], s[7] * inv - cur[7]);
                *(u32x4*)(lds + P_UB + tl * 528 + c * 2) = uw;
                float g[8]; unpack8(*(const u32x4*)(z + (size_t)row * DIN + C_PG + c), g);
                const float4 s0 = *(const float4*)(p.pool_scale + l * 256 + c), s1 = *(const float4*)(p.pool_scale + l * 256 + c + 4);
                *(float4*)(gt + tl * 260 + c) = make_float4(s0.x * silu(g[0]), s0.y * silu(g[1]), s0.z * silu(g[2]), s0.w * silu(g[3]));
                *(float4*)(gt + tl * 260 + c + 4) = make_float4(s1.x * silu(g[4]), s1.y * silu(g[5]), s1.z * silu(g[6]), s1.w * silu(g[7]));
            }
        }
        __syncthreads();
        { const int gi = wid >> 1, tt = wid & 1;
          f32x4 acc[4];
#pragma unroll
          for (int n = 0; n < 4; ++n) acc[n] = (f32x4){0.f, 0.f, 0.f, 0.f};
#pragma unroll
          for (int ks = 0; ks < 2; ++ks) { const bf16x8 a = *(const bf16x8*)(lds + P_UB + (tt * 16 + lr) * 528 + (gi * 64 + ks * 32 + lq * 8) * 2);
#pragma unroll
              for (int n = 0; n < 4; ++n) { const bf16x8 bb = *(const bf16x8*)(lds + P_PWT + (gi * 64 + n * 16 + lr) * 144 + (ks * 32 + lq * 8) * 2);
                  acc[n] = __builtin_amdgcn_mfma_f32_16x16x32_bf16(a, bb, acc[n], 0, 0, 0); } }
#pragma unroll
          for (int n = 0; n < 4; ++n)
#pragma unroll
              for (int j = 0; j < 4; ++j) { const int t = tt * 16 + lq * 4 + j, ch = gi * 64 + n * 16 + lr;
                  *(bf16_t*)(lds + P_OB + t * 528 + ch * 2) = f2bf(acc[n][j] * gt[t * 260 + ch]); } }
        __syncthreads();
        for (int it = tid; it < 1024; it += NT) { const int tl = it >> 5, c = (it & 31) * 8;
            const int row = tile < 512 ? tile * 32 + tl : MP + (tile - 512) * 32 + tl;
            *(u32x4*)(mix + (size_t)row * DM + 768 + c) = *(const u32x4*)(lds + P_OB + tl * 528 + c * 2); }
    }
    if (do_bufs)
    for (int idx = blk * NT + tid; idx < 136 * 15 * 32; idx += nblk * NT) {
        const int c = (idx & 31) * 8, r = idx >> 5, j = r % 15, bg = r / 15;
        float v[8]; float* dst;
        if (bg < 8) { unpack8(*(const u32x4*)(z + (size_t)(bg * 2048 + 2048 - 15 + j) * DIN + C_PV + c), v); dst = p.out + O_NPP + (size_t)((l * 8 + bg) * 15 + j) * 256 + c; }
        else { const int b = bg - 8, tp = j - 11; dst = p.out + O_NPS + (size_t)((l * 128 + b) * 15 + j) * 256 + c;
            if (tp < 0) { const float* sp = p.state_pool + (size_t)((l * 128 + b) * 15 + j + 4) * 256 + c; const float4 a = *(const float4*)sp, b4 = *(const float4*)(sp + 4);
                v[0] = a.x; v[1] = a.y; v[2] = a.z; v[3] = a.w; v[4] = b4.x; v[5] = b4.y; v[6] = b4.z; v[7] = b4.w; }
            else unpack8(*(const u32x4*)(z + (size_t)(MP + b * 4 + tp) * DIN + C_PV + c), v); }
        *(float4*)dst = make_float4(v[0], v[1], v[2], v[3]); *(float4*)(dst + 4) = make_float4(v[4], v[5], v[6], v[7]);
    }
    __syncthreads();
}

DI float lb_of(const Params& p, int l, int d) {
    if (l == 0) return 0.f;
    const float a0 = p.hgrn_lb[d], a1 = p.hgrn_lb[512 + d];
    return frcp(1.0f + __expf(a0 - a1));
}
DI void gate_fk(float x, float lb, float& f, float& k) {
    x = fminf(fmaxf(x, -30.f), 30.f);
    const float e = __expf(-x), sig = frcp(1.0f + e);
    f = lb + (1.0f - lb) * sig; k = (1.0f - lb) * (e * sig);
}

struct ChunkRaw { unsigned f[8], v[8], q[8]; u32x4 qm[2], km[2]; bf16x8 bS[4]; u32x2 g[4]; };
template <bool PASSC>
DI void chunk_load(ChunkRaw& r, const Params& p, int ch, int tid) {
    const int dp = tid & 63, wid = tid >> 6, lane = tid & 63, lr = lane & 15, lq = lane >> 4;
    const int b = ch >> 7, h = (ch >> 5) & 3, c = ch & 31, r0 = b * 2048 + c * 64;
    const bf16_t* z = (const bf16_t*)(p.ws + WS_Z);
    const bf16_t* S16 = (const bf16_t*)(p.ws + WS_U + 33554432) + (size_t)ch * 16384;
    const bf16_t* zrow = z + (size_t)(r0 + wid * 8) * DIN + h * 128 + 2 * dp;
    if (!PASSC) {
#pragma unroll
        for (int i = 0; i < 8; ++i) r.f[i] = *(const unsigned*)(zrow + (size_t)i * DIN + C_F);
#pragma unroll
        for (int i = 0; i < 8; ++i) r.q[i] = *(const unsigned*)(zrow + (size_t)i * DIN + C_Q);
    } else {
#pragma unroll
        for (int k = 0; k < 2; ++k) { const int u = tid + k * NT; const bf16_t* zr = z + (size_t)(r0 + (u >> 4)) * DIN + h * 128 + (u & 15) * 8;
            r.qm[k] = *(const u32x4*)(zr + C_Q); r.km[k] = *(const u32x4*)(zr + C_F); }
    }
#pragma unroll
    for (int i = 0; i < 8; ++i) r.v[i] = *(const unsigned*)(zrow + (size_t)i * DIN + C_I);
    if (PASSC) {
#pragma unroll
        for (int ks = 0; ks < 4; ++ks) r.bS[ks] = *(const bf16x8*)(S16 + (size_t)(wid * 16 + lr) * 128 + ks * 32 + lq * 8);
#pragma unroll
        for (int tt = 0; tt < 4; ++tt) r.g[tt] = *(const u32x2*)(z + (size_t)(r0 + tt * 16 + lr) * DIN + C_GB + h * 128 + wid * 16 + lq * 4);
    }
}
template <bool PASSC>
DI void hgrn_chunk(const ChunkRaw& raw, const Params& p, int l, int ch, unsigned char* lds, int tid) {
    const int dp = tid & 63, wid = tid >> 6, lane = tid & 63, lr = lane & 15, lq = lane >> 4, d0 = 2 * dp;
    const int b = ch >> 7, h = (ch >> 5) & 3, c = ch & 31, r0 = b * 2048 + c * 64;
    bf16_t* U16 = (bf16_t*)(p.ws + WS_U) + (size_t)ch * 16384;
    float* tot = (float*)(lds + L_TOT); float* eb = (float*)(lds + L_EB);
    const float lb0 = lb_of(p, l, h * 128 + d0), lb1 = lb_of(p, l, h * 128 + d0 + 1);
    const bf16x8 (&bS)[4] = raw.bS; const u32x2 (&graw)[4] = raw.g;
    float cs0[8], cs1[8], kk0[8], kk1[8]; float off0 = 0.f, off1 = 0.f, bref0 = 0.f, bref1 = 0.f, bL0 = 0.f, bL1 = 0.f;
    if (!PASSC) {
        float cum0 = 0.f, cum1 = 0.f;
#pragma unroll
        for (int i = 0; i < 8; ++i) { float f, k; gate_fk(__uint_as_float(raw.f[i] << 16), lb0, f, k); cum0 += __logf(f); cs0[i] = cum0; kk0[i] = k;
            gate_fk(__uint_as_float(raw.f[i] & 0xffff0000u), lb1, f, k); cum1 += __logf(f); cs1[i] = cum1; kk1[i] = k; }
        *(float2*)(tot + wid * 128 + d0) = make_float2(cum0, cum1);
        __syncthreads();
#pragma unroll
        for (int sgm = 0; sgm < 8; ++sgm) { const float2 tv = *(const float2*)(tot + sgm * 128 + d0);
            if (sgm < wid) { off0 += tv.x; off1 += tv.y; } if (sgm < 4) { bref0 += tv.x; bref1 += tv.y; } bL0 += tv.x; bL1 += tv.y; }
    }
    { u32x4 w0, w1;
#pragma unroll
      for (int j = 0; j < 4; ++j) { w0[j] = (raw.v[2 * j] & 0xffffu) | (raw.v[2 * j + 1] << 16); w1[j] = (raw.v[2 * j] >> 16) | (raw.v[2 * j + 1] & 0xffff0000u); }
      *(u32x4*)(lds + L_VT + d0 * 144 + wid * 16) = w0; *(u32x4*)(lds + L_VT + (d0 + 1) * 144 + wid * 16) = w1; }
    if (!PASSC) {
        float km0[8], km1[8];
        { bf16_t* zw = (bf16_t*)(p.ws + WS_Z) + (size_t)(r0 + wid * 8) * DIN + h * 128 + d0;
#pragma unroll
          for (int i = 0; i < 8; ++i) { const float b0 = fminf(fmaxf(off0 + cs0[i] - bref0, -80.f), 80.f), b1 = fminf(fmaxf(off1 + cs1[i] - bref1, -80.f), 80.f); const float e0 = __expf(b0), e1 = __expf(b1);
              km0[i] = kk0[i] * frcp(e0); km1[i] = kk1[i] * frcp(e1);
              *(unsigned*)(zw + (size_t)i * DIN + C_Q) = pk2(__uint_as_float(raw.q[i] << 16) * e0, __uint_as_float(raw.q[i] & 0xffff0000u) * e1);
              *(unsigned*)(zw + (size_t)i * DIN + C_F) = pk2(km0[i], km1[i]); } }
        u32x4 w0, w1;
#pragma unroll
        for (int j = 0; j < 4; ++j) { w0[j] = pk2(km0[2 * j], km0[2 * j + 1]); w1[j] = pk2(km1[2 * j], km1[2 * j + 1]); }
        *(u32x4*)(lds + L_ST + d0 * 144 + wid * 16) = w0; *(u32x4*)(lds + L_ST + (d0 + 1) * 144 + wid * 16) = w1;
        if (wid == 0) { *(float2*)((float*)(p.ws + WS_DEC) + (size_t)ch * 128 + d0) = make_float2(__expf(bL0), __expf(bL1));
            *(float2*)((float*)(p.ws + WS_EBR) + (size_t)ch * 128 + d0) = make_float2(__expf(bref0), __expf(bref1));
            *(float2*)(eb + d0) = make_float2(__expf(bL0 - bref0), __expf(bL1 - bref1)); }
        __syncthreads();
        f32x4 acc[8];
#pragma unroll
        for (int n = 0; n < 8; ++n) acc[n] = (f32x4){0.f, 0.f, 0.f, 0.f};
#pragma unroll
        for (int ks = 0; ks < 2; ++ks) {
            const bf16x8 bv = *(const bf16x8*)(lds + L_VT + (wid * 16 + lr) * 144 + (ks * 32 + lq * 8) * 2);
#pragma unroll
            for (int n = 0; n < 8; ++n) { const bf16x8 ak = *(const bf16x8*)(lds + L_ST + (n * 16 + lr) * 144 + (ks * 32 + lq * 8) * 2);
                acc[n] = __builtin_amdgcn_mfma_f32_16x16x32_bf16(ak, bv, acc[n], 0, 0, 0); }
        }
#pragma unroll
        for (int n = 0; n < 8; ++n) { const float4 sc = *(const float4*)(eb + n * 16 + lq * 4);
            u32x2 w2; w2.x = pk2(acc[n][0] * sc.x, acc[n][1] * sc.y); w2.y = pk2(acc[n][2] * sc.z, acc[n][3] * sc.w);
            *(u32x2*)(U16 + (size_t)(wid * 16 + lr) * 128 + n * 16 + lq * 4) = w2; }
        __syncthreads();
    } else {
#pragma unroll
        for (int k = 0; k < 2; ++k) { const int u = tid + k * NT; *(u32x4*)(lds + L_QM + (u >> 4) * 272 + (u & 15) * 16) = raw.qm[k]; *(u32x4*)(lds + L_KM + (u >> 4) * 272 + (u & 15) * 16) = raw.km[k]; }
        __syncthreads();
        { const int tt = wid >> 1;
#pragma unroll
          for (int jj = 0; jj < 2; ++jj) {
            const int st = (wid & 1) * 2 + jj; f32x4 acc = (f32x4){0.f, 0.f, 0.f, 0.f};
            if (st <= tt) {
#pragma unroll
                for (int ks = 0; ks < 4; ++ks) { const bf16x8 a = *(const bf16x8*)(lds + L_QM + (tt * 16 + lr) * 272 + (ks * 32 + lq * 8) * 2);
                    const bf16x8 bb = *(const bf16x8*)(lds + L_KM + (st * 16 + lr) * 272 + (ks * 32 + lq * 8) * 2);
                    acc = __builtin_amdgcn_mfma_f32_16x16x32_bf16(a, bb, acc, 0, 0, 0); }
            }
#pragma unroll
            for (int j = 0; j < 4; ++j) { const int t = tt * 16 + lq * 4 + j, s = st * 16 + lr;
                *(bf16_t*)(lds + L_AM + t * 144 + s * 2) = f2bf(s <= t ? acc[j] : 0.f); }
          } }
        __syncthreads();
        f32x4 acc[4];
        bf16x8 bV[2];
#pragma unroll
        for (int ks = 0; ks < 2; ++ks) bV[ks] = *(const bf16x8*)(lds + L_VT + (wid * 16 + lr) * 144 + (ks * 32 + lq * 8) * 2);
#pragma unroll
        for (int tt = 0; tt < 4; ++tt) {
            acc[tt] = (f32x4){0.f, 0.f, 0.f, 0.f};
#pragma unroll
            for (int ks = 0; ks < 4; ++ks) { const bf16x8 q = *(const bf16x8*)(lds + L_QM + (tt * 16 + lr) * 272 + (ks * 32 + lq * 8) * 2);
                acc[tt] = __builtin_amdgcn_mfma_f32_16x16x32_bf16(bS[ks], q, acc[tt], 0, 0, 0); }
#pragma unroll
            for (int ks = 0; ks < 2; ++ks) { if (ks * 32 <= tt * 16 + 15) { const bf16x8 am = *(const bf16x8*)(lds + L_AM + (tt * 16 + lr) * 144 + (ks * 32 + lq * 8) * 2);
                acc[tt] = __builtin_amdgcn_mfma_f32_16x16x32_bf16(bV[ks], am, acc[tt], 0, 0, 0); } }
        }
        float* ssq = (float*)(lds + L_ST);
#pragma unroll
        for (int tt = 0; tt < 4; ++tt) { float ss = acc[tt][0] * acc[tt][0] + acc[tt][1] * acc[tt][1] + acc[tt][2] * acc[tt][2] + acc[tt][3] * acc[tt][3];
            ss += __shfl_xor(ss, 16, 64); ss += __shfl_xor(ss, 32, 64);
            if (lq == 0) ssq[(tt * 16 + lr) * 8 + wid] = ss; }
        __syncthreads();
        bf16_t* mix = (bf16_t*)(p.ws + WS_XB);
        const float4 ng = *(const float4*)(p.hgrn_norm_g + l * 512 + h * 128 + wid * 16 + lq * 4);
#pragma unroll
        for (int tt = 0; tt < 4; ++tt) { const int t = tt * 16 + lr;
            const float4 s0 = *(const float4*)(ssq + t * 8), s1 = *(const float4*)(ssq + t * 8 + 4);
            const float rs = rsqrtf((s0.x + s0.y + s0.z + s0.w + s1.x + s1.y + s1.z + s1.w) * (1.0f / 128.0f) + EPS);
            const float g0 = __uint_as_float(graw[tt].x << 16), g1 = __uint_as_float(graw[tt].x & 0xffff0000u), g2 = __uint_as_float(graw[tt].y << 16), g3 = __uint_as_float(graw[tt].y & 0xffff0000u);
            u32x2 w2; w2.x = pk2(acc[tt][0] * rs * ng.x * silu(g0), acc[tt][1] * rs * ng.y * silu(g1)); w2.y = pk2(acc[tt][2] * rs * ng.z * silu(g2), acc[tt][3] * rs * ng.w * silu(g3));
            *(u32x2*)(mix + (size_t)(r0 + t) * DM + 256 + h * 128 + wid * 16 + lq * 4) = w2; }
        __syncthreads();
    }
}

template <bool PASSC>
DI void hgrn_pass(const Params& p, int l, unsigned char* lds) {
    const int tid = ltid();
    if (PASSC_PREFETCH || !PASSC) {
        ChunkRaw ra, rb;
        chunk_load<PASSC>(ra, p, (int)blockIdx.x, tid);
        chunk_load<PASSC>(rb, p, (int)blockIdx.x + GRID, tid);
        hgrn_chunk<PASSC>(ra, p, l, (int)blockIdx.x, lds, tid);
        chunk_load<PASSC>(ra, p, (int)blockIdx.x + 2 * GRID, tid);
        hgrn_chunk<PASSC>(rb, p, l, (int)blockIdx.x + GRID, lds, tid);
        chunk_load<PASSC>(rb, p, (int)blockIdx.x + 3 * GRID, tid);
        hgrn_chunk<PASSC>(ra, p, l, (int)blockIdx.x + 2 * GRID, lds, tid);
        hgrn_chunk<PASSC>(rb, p, l, (int)blockIdx.x + 3 * GRID, lds, tid);
    } else {
        for (int k = 0; k < 4; ++k) { ChunkRaw ra; chunk_load<PASSC>(ra, p, (int)blockIdx.x + k * GRID, tid); hgrn_chunk<PASSC>(ra, p, l, (int)blockIdx.x + k * GRID, lds, tid); }
    }
}

DI void phase_scan(const Params& p, int l, int idx_lo, int idx_hi, int stride) {
    const bf16_t* U16 = (const bf16_t*)(p.ws + WS_U); bf16_t* S16 = (bf16_t*)(p.ws + WS_U + 33554432);
    const float* dec = (const float*)(p.ws + WS_DEC); const float* ebr = (const float*)(p.ws + WS_EBR);
    for (int idx = idx_lo + ltid(); idx < idx_hi; idx += stride) {
        const int d4 = (idx & 31) * 4, e = (idx >> 5) & 127, bh = idx >> 12;
        float4 s = make_float4(0.f, 0.f, 0.f, 0.f);
        const size_t o0 = (size_t)bh * 32 * 16384 + e * 128 + d4; const float* pd0 = dec + (size_t)bh * 32 * 128 + d4; const float* pe0 = ebr + (size_t)bh * 32 * 128 + d4;
        for (int cb = 0; cb < 32; cb += 8) {
            u32x2 u[8]; float4 dc[8], ee[8];
#pragma unroll
            for (int j = 0; j < 8; ++j) { u[j] = *(const u32x2*)(U16 + o0 + (size_t)(cb + j) * 16384); dc[j] = *(const float4*)(pd0 + (cb + j) * 128); ee[j] = *(const float4*)(pe0 + (cb + j) * 128); }
#pragma unroll
            for (int j = 0; j < 8; ++j) { u32x2 w2; w2.x = pk2(s.x * ee[j].x, s.y * ee[j].y); w2.y = pk2(s.z * ee[j].z, s.w * ee[j].w);
                *(u32x2*)(S16 + o0 + (size_t)(cb + j) * 16384) = w2;
                s.x = dc[j].x * s.x + __uint_as_float(u[j].x << 16); s.y = dc[j].y * s.y + __uint_as_float(u[j].x & 0xffff0000u);
                s.z = dc[j].z * s.z + __uint_as_float(u[j].y << 16); s.w = dc[j].w * s.w + __uint_as_float(u[j].y & 0xffff0000u); }
        }
        float* o = p.out + O_NHP + (size_t)(l * 32 + bh) * 16384 + e;
        o[(d4 + 0) * 128] = s.x; o[(d4 + 1) * 128] = s.y; o[(d4 + 2) * 128] = s.z; o[(d4 + 3) * 128] = s.w;
    }
}

DI void sample_ld(const Params& p, int l, int item, int tid, float4 (&S)[8], bf16_t (&zs)[5]) {
    const int b = item >> 2, h = item & 3, e4 = (tid & 31) * 4, dg = tid >> 5;
    const float* S0 = p.state_hgrn + (size_t)((l * 128 + b) * 4 + h) * 16384;
    { const bf16_t* zr = (const bf16_t*)(p.ws + WS_Z) + (size_t)(MP + b * 4 + (tid >> 7)) * DIN + h * 128 + (tid & 127); zs[0] = zr[C_F]; zs[1] = zr[C_Q]; zs[2] = zr[C_I]; zs[3] = zr[C_GB]; zs[4] = 0; }
#pragma unroll
    for (int i = 0; i < 8; ++i) S[i] = ldnt4(S0 + (size_t)(dg + 16 * i) * 128 + e4);
}
DI void hgrn_sample(const Params& p, int l, int item, unsigned char* lds, int tid, float4 (&S)[8], const bf16_t (&zs)[5]) {
    const int b = item >> 2, h = item & 3, wid = tid >> 6, lane = tid & 63;
    const bf16_t* z = (const bf16_t*)(p.ws + WS_Z);
    float* sf = (float*)lds; float* sk = sf + 512; float* sq = sk + 512; float* sv = sq + 512; float* sg = sv + 512; float* red = sg + 512; float* ssq = red + 8192;
    { const int d = tid & 127;
      float f, k; gate_fk(bf2f(zs[0]), lb_of(p, l, h * 128 + d), f, k);
      sf[tid] = f; sk[tid] = k; sq[tid] = bf2f(zs[1]); sv[tid] = bf2f(zs[2]); sg[tid] = bf2f(zs[3]); }
    const int e4 = (tid & 31) * 4, dg = tid >> 5;
    float* S1 = p.out + O_NHS + (size_t)((l * 128 + b) * 4 + h) * 16384;
    __syncthreads();
#pragma unroll
    for (int t = 0; t < 4; ++t) {
        const float4 v = *(const float4*)(sv + t * 128 + e4); float4 a = make_float4(0.f, 0.f, 0.f, 0.f);
#pragma unroll
        for (int i = 0; i < 8; ++i) { const int d = t * 128 + dg + 16 * i; const float f = sf[d], k = sk[d], q = sq[d];
            S[i].x = f * S[i].x + k * v.x; S[i].y = f * S[i].y + k * v.y; S[i].z = f * S[i].z + k * v.z; S[i].w = f * S[i].w + k * v.w;
            a.x += q * S[i].x; a.y += q * S[i].y; a.z += q * S[i].z; a.w += q * S[i].w; }
        *(float4*)(red + (t * 16 + dg) * 128 + e4) = a;
    }
#pragma unroll
    for (int i = 0; i < 8; ++i) stnt4(S1 + (size_t)(dg + 16 * i) * 128 + e4, S[i]);
    __syncthreads();
    { const int t = tid >> 7, e = tid & 127; float o = 0.f;
#pragma unroll
      for (int g = 0; g < 16; ++g) o += red[(t * 16 + g) * 128 + e];
      const float ss = wave_sum(o * o);
      if (lane == 0) ssq[wid] = ss;
      __syncthreads();
      const float rs = rsqrtf((ssq[2 * t] + ssq[2 * t + 1]) * (1.0f / 128.0f) + EPS);
      ((bf16_t*)(p.ws + WS_XB))[(size_t)(MP + b * 4 + t) * DM + 256 + h * 128 + e] = f2bf(o * rs * p.hgrn_norm_g[l * 512 + h * 128 + e] * silu(sg[tid])); }
    __syncthreads();
}
DI void phase_sample(const Params& p, int l, unsigned char* lds) {
    const int tid = ltid(), bk = (int)blockIdx.x; float4 Sa[8], Sb[8]; bf16_t za[5], zb[5];
    sample_ld(p, l, bk, tid, Sa, za);
    if (bk >= 16) sample_ld(p, l, bk + GRID, tid, Sb, zb);
    hgrn_sample(p, l, bk, lds, tid, Sa, za);
    if (bk >= 32 && bk < 48) sample_ld(p, l, bk - 32 + GRID, tid, Sa, za);
    if (bk >= 16) hgrn_sample(p, l, bk + GRID, lds, tid, Sb, zb);
    if (bk >= 32 && bk < 48) hgrn_sample(p, l, bk - 32 + GRID, lds, tid, Sa, za);
}

DI Params load_params() {
    Params p{};
#if defined(__HIP_DEVICE_COMPILE__)
    typedef const __attribute__((address_space(4))) Params* KParams;
    KParams kp = (KParams)__builtin_amdgcn_kernarg_segment_ptr(); asm volatile("" : "+s"(kp));
    p.x_prompt = kp->x_prompt; p.x_sample = kp->x_sample; p.state_conv = kp->state_conv; p.state_hgrn = kp->state_hgrn; p.state_pool = kp->state_pool; p.norm_g = kp->norm_g; p.w_in = kp->w_in;
    p.conv_w = kp->conv_w; p.hgrn_lb = kp->hgrn_lb; p.hgrn_norm_g = kp->hgrn_norm_g; p.pool_w = kp->pool_w; p.pool_scale = kp->pool_scale; p.w_out = kp->w_out; p.final_norm_g = kp->final_norm_g;
    p.out = kp->out; p.ws = kp->ws;
#endif
    return p;
}
#define LP() load_params()
__global__ __launch_bounds__(512, 2) void hymba_fwd(Params p_unused) {
    extern __shared__ __attribute__((aligned(16))) unsigned char shm[];
    cg::grid_group grid = cg::this_grid();
    volatile LAS unsigned* xst = (volatile LAS unsigned*)(shm + 131072);
    if (threadIdx.x == 0) { xst[0] = 0u; xst[1] = 0u; xst[2] = 0u; xst[3] = 0u; }
    __syncthreads();
    { const Params p = LP(); (void)xcd_barrier_post((unsigned*)(p.ws + WS_BAR), xst); }
#define GSYNC() do { const Params p_ = LP(); XcdBarrier b_; b_.bar = (unsigned*)(p_.ws + WS_BAR); b_.x = xb_xcc_id(); b_.st = xst; xcd_barrier(b_); } while (0)
    { const Params p = LP(); phase_weights(p, shm, 0, 896, (int)blockIdx.x, (int)gridDim.x); }
    { const Params p = LP(); phase_norm0(p); }
    { const Params p = LP(); if (p.ws == nullptr) grid.sync(); }
    GSYNC();
    for (int l = 0; l < 2; ++l) {
        { const Params p = LP(); pg8::Gemm g; g.A = (const bf16_t*)(p.ws + (l == 0 ? WS_XB : WS_U)); g.Bt = (const bf16_t*)(p.ws + WS_WIN) + (size_t)l * DIN * DM; g.M = MT; g.N = DIN; g.K = DM;
          pg8::StaticOrder S; S.init(MT, DIN, (int)gridDim.x, (int)blockIdx.x); EpiZ E; E.O = (bf16_t*)(p.ws + WS_Z); E.ssq = l == 0 ? nullptr : (const float*)(p.ws + WS_SSQ) + (size_t)l * MT;
          pg8::gemm_phase<EpiZ, pg8::StaticOrder, false>((PG8_LAS unsigned char*)shm, g, S, E, nullptr);
        }
        if (blockIdx.x >= 156) { const Params p = LP(); phase_weights(p, shm, l == 0 ? 896 : 2048, l == 0 ? 2048 : 2304, (int)blockIdx.x - 156, (int)gridDim.x - 156); }
        GSYNC();
        { const Params p = LP(); hgrn_pass<false>(p, l, shm); }
        { const Params p = LP(); phase_sample(p, l, shm); }
        if (blockIdx.x >= 48 && blockIdx.x < 80) { const Params p = LP(); phase_conv(p, l, MP, MT, (int)blockIdx.x - 48, 32); }
        { const Params p = LP(); if (blockIdx.x < 16) phase_pool(p, l, shm, 512, 528, (int)blockIdx.x, 16, false); }
        if (blockIdx.x >= 80) { const Params p = LP(); phase_pool(p, l, shm, 0, 0, (int)blockIdx.x - 80, (int)gridDim.x - 80, true, false); }
        GSYNC();
        if (blockIdx.x < 8) { const Params p = LP(); float* xs = p.out + O_Y + (size_t)MP * DM; pg8::Gemm g; g.A = (const bf16_t*)(p.ws + WS_XB) + (size_t)MP * DM; g.Bt = (const bf16_t*)(p.ws + WS_WOUT) + (size_t)l * DM * DM; g.M = MS; g.N = DM; g.K = DM;
          pg8::StaticOrder S; S.init(MS, DM, (int)gridDim.x, (int)blockIdx.x); EpiRes E; E.X = xs; E.src = l == 0 ? p.x_sample : xs; E.ssq = (float*)(p.ws + WS_SSQ) + (size_t)(l + 1) * MT + MP; E.xbn = l == 0 ? (bf16_t*)(p.ws + WS_XSN) : nullptr;
          pg8::gemm_phase<EpiRes, pg8::StaticOrder, false>((PG8_LAS unsigned char*)shm, g, S, E, nullptr); }
        { const Params p = LP(); phase_pool(p, l, shm, 0, 0, (int)blockIdx.x, (int)gridDim.x, false, true); }
        { unsigned nxt = 0u;
          if (threadIdx.x == 0) { const Params p = LP(); nxt = __hip_atomic_fetch_add((unsigned*)(p.ws + WS_BAR) + 3584 + 64 * l, 1u, __ATOMIC_RELAXED, __HIP_MEMORY_SCOPE_AGENT); }
          for (;;) {
              if (threadIdx.x == 0) xst[2] = nxt;
              __syncthreads();
              const int item = (int)xst[2];
              __syncthreads();
              if (item >= 1280) break;
              if (threadIdx.x == 0) { const Params p = LP(); nxt = __hip_atomic_fetch_add((unsigned*)(p.ws + WS_BAR) + 3584 + 64 * l, 1u, __ATOMIC_RELAXED, __HIP_MEMORY_SCOPE_AGENT); }
              if (item < 256) { const Params p = LP(); phase_scan(p, l, item * NT, item * NT + NT, NT); }
              else if (item < 768) { const Params p = LP(); phase_pool(p, l, shm, item - 256, item - 255, 0, 1, false, false); }
              else { const Params p = LP(); phase_conv_prompt(p, l, (item - 768) * 1024, (item - 768) * 1024 + 1024, NT); }
          } }
        GSYNC();
        { const Params p = LP(); hgrn_pass<true>(p, l, shm); }
        GSYNC();
        if (l == 0) { const Params p = LP(); const u32x4* cs = (const u32x4*)(p.ws + WS_XSN); u32x4* cd = (u32x4*)(p.ws + WS_U + (size_t)MP * DM * 2);
          for (int i = blockIdx.x * NT + ltid(); i < 65536; i += gridDim.x * NT) cd[i] = cs[i]; }
        { const Params p = LP(); float* xs = p.out + O_Y; pg8::Gemm g; g.A = (const bf16_t*)(p.ws + WS_XB); g.Bt = (const bf16_t*)(p.ws + WS_WOUT) + (size_t)l * DM * DM; g.M = MP; g.N = DM; g.K = DM;
          pg8::StaticOrder S; S.init(MP, DM, (int)gridDim.x, (int)blockIdx.x); EpiRes E; E.X = xs; E.src = l == 0 ? p.x_prompt : xs; E.ssq = (float*)(p.ws + WS_SSQ) + (size_t)(l + 1) * MT; E.xbn = l == 0 ? (bf16_t*)(p.ws + WS_U) : nullptr;
          pg8::gemm_phase<EpiRes, pg8::StaticOrder, false>((PG8_LAS unsigned char*)shm, g, S, E, nullptr); }
        GSYNC();
        if (l == 1) { const Params p = LP(); phase_final(p); }
    }
}

extern "C" void kernel_launch(void* const* d_in, const int* in_sizes, int n_in, void* d_out, int out_size, void* d_ws, size_t ws_size, hipStream_t stream) {
    static int grid = 0;
    if (grid == 0) {
        if (n_in != 14 || out_size != (int)O_END || ws_size < WS_END) { fprintf(stderr, "kernel_launch: unexpected shapes: n_in %d out %d ws %zu\n", n_in, out_size, ws_size); grid = -1; return; }
        int dev = 0, cus = 0, per_cu = 0;
        (void)hipGetDevice(&dev); (void)hipDeviceGetAttribute(&cus, hipDeviceAttributeMultiprocessorCount, dev);
        if (hipFuncSetAttribute((const void*)hymba_fwd, hipFuncAttributeMaxDynamicSharedMemorySize, LDS_BYTES) != hipSuccess) { fprintf(stderr, "kernel_launch: hipFuncSetAttribute failed\n"); grid = -1; return; }
        if (hipOccupancyMaxActiveBlocksPerMultiprocessor(&per_cu, (const void*)hymba_fwd, NT, LDS_BYTES) != hipSuccess || per_cu < 1) { fprintf(stderr, "kernel_launch: occupancy query failed (%d)\n", per_cu); (void)hipGetLastError(); per_cu = 1; }
        if (cus < GRID) { fprintf(stderr, "kernel_launch: built for a %d-CU device, found %d CUs\n", GRID, cus); grid = -1; return; }
        grid = GRID;
    }
    if (grid < 0) return;
    Params p{};
    p.x_prompt = (const float*)d_in[0]; p.x_sample = (const float*)d_in[1]; p.state_conv = (const float*)d_in[2]; p.state_hgrn = (const float*)d_in[3]; p.state_pool = (const float*)d_in[4];
    p.norm_g = (const float*)d_in[5]; p.w_in = (const float*)d_in[6]; p.conv_w = (const float*)d_in[7]; p.hgrn_lb = (const float*)d_in[8]; p.hgrn_norm_g = (const float*)d_in[9];
    p.pool_w = (const float*)d_in[10]; p.pool_scale = (const float*)d_in[11]; p.w_out = (const float*)d_in[12]; p.final_norm_g = (const float*)d_in[13];
    p.out = (float*)d_out; p.ws = (unsigned char*)d_ws;
    if (hipMemsetAsync((char*)d_ws + WS_BAR, 0, 16384, stream) != hipSuccess) { fprintf(stderr, "kernel_launch: memset of barrier words failed\n"); return; }
    void* args[] = {&p};
    const hipError_t e = hipLaunchCooperativeKernel((const void*)hymba_fwd, dim3(grid), dim3(NT), args, LDS_BYTES, stream);
    if (e != hipSuccess) fprintf(stderr, "kernel_launch: cooperative launch failed: %s (grid %d)\n", hipGetErrorString(e), grid);
}
```
